# Optimizing an MI355X kernel written in HIP

```python
import jax, jax.numpy as jnp
from jax import lax
import numpy as np

D_MODEL = 1024
BATCH = 8
SEQ = 2048
DEPTH = 4

GRID_W = 64
CTX_LEN = 256
HEAD_DIM = 64
N_HEADS_NA = D_MODEL // (2 * HEAD_DIM)
N_HEADS_GQA = D_MODEL // (2 * HEAD_DIM)
N_KV_GQA = N_HEADS_GQA // 4
W_NA = N_HEADS_NA * HEAD_DIM
W_GQA = N_HEADS_GQA * HEAD_DIM
W_KV = N_KV_GQA * HEAD_DIM
MIX_WIDTH = W_NA + W_GQA
IN_COLS = 3 * W_NA + W_GQA + 2 * W_KV
SPLITS = (W_NA, 2 * W_NA, 3 * W_NA, 3 * W_NA + W_GQA, 3 * W_NA + W_GQA + W_KV)
MAX_WIN_H = 8
WIN_W = 16
Q_BLOCK = 128
ROPE_THETA = 10000.0
D_FF = -(-8 * D_MODEL // (3 * 256)) * 256
EPS = 1e-6

kernel_name = 'hybrid_na_gqa_dit_trunk'


def rms_norm(x, g):
    xf = x.astype(jnp.float32)
    y = xf * lax.rsqrt(jnp.mean(xf * xf, axis=-1, keepdims=True) + EPS)
    return (y * g.astype(jnp.float32)).astype(x.dtype)


def modulate(h, shift, scale):
    return h * (1 + scale) + shift


def adaln_params(cond, w_ada, b_ada):
    m = jax.nn.silu(cond) @ w_ada + b_ada
    return jnp.split(m, 6, axis=-1)


def axial_rope_tables(n_tokens):
    t = jnp.arange(n_tokens, dtype=jnp.int32)
    half = HEAD_DIM // 2
    inv_freq = ROPE_THETA ** (-jnp.arange(0, half, 2, dtype=jnp.float32) / half)
    row = (t // GRID_W).astype(jnp.float32)[:, None] * inv_freq
    col = (t % GRID_W).astype(jnp.float32)[:, None] * inv_freq
    return (jnp.cos(row), jnp.sin(row), jnp.cos(col), jnp.sin(col))


def rotate(x, cos, sin):
    x1, x2 = jnp.split(x, 2, axis=-1)
    cos = cos[:, None, :]
    sin = sin[:, None, :]
    return jnp.concatenate([x1 * cos - x2 * sin, x2 * cos + x1 * sin], axis=-1)


def apply_axial_rope(x, tabs):
    cr, sr, cc, sc = tabs
    xr, xc = jnp.split(x.astype(jnp.float32), 2, axis=-1)
    return jnp.concatenate([rotate(xr, cr, sr), rotate(xc, cc, sc)], axis=-1).astype(x.dtype)


def project_heads(h, w_in, qn_a, kn_a, qn_b, kn_b):
    B, L, _ = h.shape
    p = h @ w_in
    qa, ka, va, qb, kb, vb = jnp.split(p, SPLITS, axis=-1)
    heads = lambda t: t.reshape(B, L, -1, HEAD_DIM)
    return (rms_norm(heads(qa), qn_a), rms_norm(heads(ka), kn_a), heads(va),
            rms_norm(heads(qb), qn_b), rms_norm(heads(kb), kn_b), heads(vb))


def neighbourhood_attention(q, k, v, kc, vc, rpb):
    B, S, H, dh = q.shape
    rows = S // GRID_W
    wh = min(MAX_WIN_H, rows)
    qg = q.reshape(B, rows, GRID_W, H, dh)
    kg = k.reshape(B, rows, GRID_W, H, dh)
    vg = v.reshape(B, rows, GRID_W, H, dh)
    r = jnp.arange(rows, dtype=jnp.int32)
    rs = jnp.clip(r - wh // 2, 0, rows - wh)
    row_idx = rs[:, None] + jnp.arange(wh, dtype=jnp.int32)[None, :]
    k_rows = kg[:, row_idx]
    v_rows = vg[:, row_idx]
    cidx = jnp.arange(GRID_W, dtype=jnp.int32)
    cs = jnp.clip(cidx - WIN_W // 2, 0, GRID_W - WIN_W)
    col_ok = (cidx[None, :] >= cs[:, None]) & (cidx[None, :] < cs[:, None] + WIN_W)
    dr = row_idx - r[:, None] + (MAX_WIN_H - 1)
    dc = jnp.clip(cidx[None, :] - cidx[:, None], -(WIN_W - 1), WIN_W - 1) + (WIN_W - 1)
    bias = rpb[:, dr[:, None, :, None], dc[None, :, None, :]]
    scale = dh ** -0.5
    s_win = jnp.einsum('brqhd,brjkhd->bhrqjk', qg, k_rows,
                       preferred_element_type=jnp.float32) * scale + bias[None].astype(jnp.float32)
    s_win = jnp.where(col_ok[None, None, None, :, None, :], s_win, -jnp.inf)
    s_win = s_win.reshape(B, H, rows, GRID_W, wh * GRID_W)
    s_ctx = jnp.einsum('brqhd,bchd->bhrqc', qg, kc, preferred_element_type=jnp.float32) * scale
    p = jax.nn.softmax(jnp.concatenate([s_win, s_ctx], axis=-1), axis=-1).astype(v.dtype)
    p_win = p[..., :wh * GRID_W].reshape(B, H, rows, GRID_W, wh, GRID_W)
    p_ctx = p[..., wh * GRID_W:]
    o = (jnp.einsum('bhrqjk,brjkhd->brqhd', p_win, v_rows)
         + jnp.einsum('bhrqc,bchd->brqhd', p_ctx, vc))
    return o.reshape(B, S, H * dh)


def gqa_blocked(q, k, v, kc, vc):
    B, S, Hq, dh = q.shape
    Hkv = k.shape[2]
    g = Hq // Hkv
    k_all = jnp.concatenate([k, kc], axis=1)
    v_all = jnp.concatenate([v, vc], axis=1)
    qb = q.reshape(B, S // Q_BLOCK, Q_BLOCK, Hkv, g, dh).transpose(1, 0, 2, 3, 4, 5)
    scale = dh ** -0.5

    def block(q_blk):
        s = jnp.einsum('bqkgd,bskd->bkgqs', q_blk, k_all, preferred_element_type=jnp.float32) * scale
        p = jax.nn.softmax(s, axis=-1).astype(v_all.dtype)
        return jnp.einsum('bkgqs,bskd->bqkgd', p, v_all)

    o = lax.map(block, qb)
    return o.transpose(1, 0, 2, 3, 4, 5).reshape(B, S, Hq * dh)


def context_self_attention(q, k, v):
    B, C, Hq, dh = q.shape
    Hkv = k.shape[2]
    qg = q.reshape(B, C, Hkv, Hq // Hkv, dh)
    s = jnp.einsum('bqkgd,bskd->bkgqs', qg, k, preferred_element_type=jnp.float32) * dh ** -0.5
    p = jax.nn.softmax(s, axis=-1).astype(v.dtype)
    return jnp.einsum('bkgqs,bskd->bqkgd', p, v).reshape(B, C, Hq * dh)


def swiglu(h, w_gate, w_up, w_down):
    return (jax.nn.silu(h @ w_gate) * (h @ w_up)) @ w_down


def setup_inputs(seed: int = 0) -> dict:
    key = jax.random.key(seed)
    ks = jax.random.split(key, 18)
    nrm = lambda k, shape, s: jax.random.normal(k, shape, jnp.float32) * s
    return {
        'x': nrm(ks[0], (BATCH, SEQ, D_MODEL), 1.0),
        'c': nrm(ks[1], (BATCH, D_MODEL), 1.0),
        'ctx': nrm(ks[2], (BATCH, CTX_LEN, D_MODEL), 1.0),
        'c_ctx': nrm(ks[3], (D_MODEL,), 1.0),
        'w_ada': nrm(ks[4], (DEPTH, D_MODEL, 6 * D_MODEL), 0.5 * D_MODEL ** -0.5),
        'b_ada': nrm(ks[5], (DEPTH, 6 * D_MODEL), 0.02),
        'attn_norm': 1.0 + nrm(ks[6], (DEPTH, D_MODEL), 0.02),
        'w_in': nrm(ks[7], (DEPTH, D_MODEL, IN_COLS), D_MODEL ** -0.5),
        'q_norm_a': 1.0 + nrm(ks[8], (DEPTH, HEAD_DIM), 0.02),
        'k_norm_a': 1.0 + nrm(ks[9], (DEPTH, HEAD_DIM), 0.02),
        'q_norm_b': 1.0 + nrm(ks[10], (DEPTH, HEAD_DIM), 0.02),
        'k_norm_b': 1.0 + nrm(ks[11], (DEPTH, HEAD_DIM), 0.02),
        'rpb': nrm(ks[12], (DEPTH, N_HEADS_NA, 2 * MAX_WIN_H - 1, 2 * WIN_W - 1), 0.1),
        'w_out': nrm(ks[13], (DEPTH, MIX_WIDTH, D_MODEL), MIX_WIDTH ** -0.5),
        'ffn_norm': 1.0 + nrm(ks[14], (DEPTH, D_MODEL), 0.02),
        'w_gate': nrm(ks[15], (DEPTH, D_MODEL, D_FF), D_MODEL ** -0.5),
        'w_up': nrm(ks[16], (DEPTH, D_MODEL, D_FF), D_MODEL ** -0.5),
        'w_down': nrm(ks[17], (DEPTH, D_FF, D_MODEL), D_FF ** -0.5),
    }


def reference(x, c, ctx, c_ctx, w_ada, b_ada, attn_norm, w_in, q_norm_a, k_norm_a,
              q_norm_b, k_norm_b, rpb, w_out, ffn_norm, w_gate, w_up, w_down):
    B, S, _ = x.shape
    tabs = axial_rope_tables(S)
    for l in range(DEPTH):
        last = l == DEPTH - 1
        sh1, sc1, g1, sh2, sc2, g2 = [m[:, None, :] for m in adaln_params(c, w_ada[l], b_ada[l])]
        csh1, csc1, cg1, csh2, csc2, cg2 = adaln_params(c_ctx, w_ada[l], b_ada[l])
        h = modulate(rms_norm(x, attn_norm[l]), sh1, sc1)
        hc = modulate(rms_norm(ctx, attn_norm[l]), csh1, csc1)
        qa, ka, va, qb, kb, vb = project_heads(h, w_in[l], q_norm_a[l], k_norm_a[l], q_norm_b[l], k_norm_b[l])
        cqa, cka, cva, cqb, ckb, cvb = project_heads(hc, w_in[l], q_norm_a[l], k_norm_a[l], q_norm_b[l], k_norm_b[l])
        qb = apply_axial_rope(qb, tabs)
        kb = apply_axial_rope(kb, tabs)
        oa = neighbourhood_attention(qa, ka, va, cka, cva, rpb[l])
        ob = gqa_blocked(qb, kb, vb, ckb, cvb)
        x = x + g1 * (jnp.concatenate([oa, ob], axis=-1) @ w_out[l])
        x = x + g2 * swiglu(modulate(rms_norm(x, ffn_norm[l]), sh2, sc2), w_gate[l], w_up[l], w_down[l])
        if not last:
            oc = jnp.concatenate([context_self_attention(cqa, cka, cva),
                                  context_self_attention(cqb, ckb, cvb)], axis=-1)
            ctx = ctx + cg1 * (oc @ w_out[l])
            ctx = ctx + cg2 * swiglu(modulate(rms_norm(ctx, ffn_norm[l]), csh2, csc2),
                                     w_gate[l], w_up[l], w_down[l])
    return x
```

```cpp
#include <hip/hip_runtime.h>
#include <hip/hip_cooperative_groups.h>
#include <hip/hip_bf16.h>
#include <cstdio>
#include <cstdint>
namespace cg = cooperative_groups;

constexpr int NB = 8, SEQ = 2048, DM = 1024, DEPTH = 4, CTXL = 256, HD = 64;
constexpr int NLAT = NB * SEQ;
constexpr int NCTX = NB * CTXL;
constexpr int NROWS = NLAT + NCTX;
constexpr int QKVN = 2304, FF = 2816, GUN = 2 * FF;
constexpr float EPS = 1e-6f;
constexpr float LOG2E = 1.4426950408889634f;
constexpr float C2 = 0.125f * LOG2E;
namespace pg8 {
#define PG8_LAS __attribute__((address_space(3)))
typedef unsigned short bf16_t;
typedef short bf16x8 __attribute__((ext_vector_type(8)));
typedef float f32x4 __attribute__((ext_vector_type(4)));
typedef unsigned u32x4 __attribute__((ext_vector_type(4)));
constexpr int BM = 256, BK = 64, HALF = 128, HTB = HALF * BK * 2  , STAGE_BYTES = 8 * HTB, NXCD = 8, WGM = 8;

__host__ __device__ __forceinline__ int lds_byte(int r, int c) { const int st = (r >> 4) * 2 + (c >> 5), rr = r & 15, cc = c & 31, ob = rr * 64 + cc * 2; return st * 1024 + (ob ^ (((ob >> 9) & 1) << 5)); }
__host__ __device__ __forceinline__ void stage_rc(int b, int& R, int& C) { const int st = b / 1024, sb = b % 1024, swz = sb ^ (((sb >> 9) & 1) << 5); R = (st >> 1) * 16 + swz / 64; C = (st & 1) * 32 + (swz % 64) / 2; }
__host__ __device__ __forceinline__ int perm32(int rho) { const int n = rho >> 4, i = rho & 15; return 8 * (i >> 2) + 4 * n + (i & 3); }

struct Unit { int pm, pn; };
struct Gemm { const bf16_t* A; const bf16_t* Bt; int M, N, K; };

struct StaticOrder {
    int nM, nN, nwg, G, c;
    __host__ __device__ void init(int M, int N, int G_, int c_) { nM = M / BM; nN = N / BM; nwg = nM * nN; G = G_; c = c_; }
    __host__ __device__ bool next(int i, Unit& u) const {
        const long L = (long)i * G + c; if (L >= nwg) return false;
        int wgid = (int)L; { const int q = nwg / NXCD, r = nwg % NXCD, xcd = wgid % NXCD, off = wgid / NXCD; wgid = (xcd < r ? xcd * (q + 1) : r * (q + 1) + (xcd - r) * q) + off; }
        const int nig = WGM * nN, gid = wgid / nig, fm = gid * WGM, gsz = (nM - fm) < WGM ? (nM - fm) : WGM;
        u.pm = fm + ((wgid % nig) % gsz); u.pn = (wgid % nig) / gsz; return true;
    }
    __device__ __forceinline__ void a_ready(const Unit&) const {}
    __device__ __forceinline__ void done(const Unit&) const {}
};

__device__ __forceinline__ unsigned cvt_pk_bf16(float lo, float hi) { unsigned r; asm volatile("v_cvt_pk_bf16_f32 %0, %1, %2" : "=v"(r) : "v"(lo), "v"(hi)); return r; }
typedef unsigned u32x2 __attribute__((ext_vector_type(2)));

struct EpiQKV {
    static constexpr bool PERM = false, AFTER_DRAIN = false;
    bf16_t* QKV; const float* qn_a; const float* kn_a; const float* qn_b; const float* kn_b; const float* ropeC; const float* ropeS;
    __device__ __forceinline__ void operator()(const f32x4 (&acc)[2][2][4][2], const Unit& u, int wr, int wc, int fr, int fq) const {
        const int pn = u.pn;
        int kind; bool rope; const float* gain;
        if (pn < 2) { kind = 0; gain = qn_a; rope = false; }
        else if (pn < 4) { kind = 1; gain = kn_a; rope = false; }
        else if (pn < 6) { kind = 2; gain = qn_a; rope = false; }
        else if (pn < 8) { kind = 0; gain = qn_b; rope = true; }
        else if (wc < 2) { kind = 1; gain = kn_b; rope = true; }
        else { kind = 2; gain = kn_b; rope = false; }
        rope = rope && (u.pm < 64);
        f32x4 gv[2][2];
#pragma unroll
        for (int bj = 0; bj < 2; ++bj)
#pragma unroll
            for (int n = 0; n < 2; ++n) gv[bj][n] = *(const f32x4*)(gain + 32 * bj + 16 * n + 4 * fq);
        const float qs = (kind == 0) ? C2 : 1.f;
#pragma unroll
        for (int ai = 0; ai < 2; ++ai)
#pragma unroll
            for (int m = 0; m < 4; ++m) {
                const int row = u.pm * BM + ai * HALF + wr * 64 + m * 16 + fr;
                f32x4 v[2][2];
#pragma unroll
                for (int bj = 0; bj < 2; ++bj)
#pragma unroll
                    for (int n = 0; n < 2; ++n) v[bj][n] = acc[ai][bj][m][n];
                if (kind != 2) {
                    float ss = 0.f;
#pragma unroll
                    for (int bj = 0; bj < 2; ++bj)
#pragma unroll
                        for (int n = 0; n < 2; ++n) { const f32x4 x = v[bj][n]; ss += (x[0] * x[0] + x[1] * x[1]) + (x[2] * x[2] + x[3] * x[3]); }
                    ss += __shfl_xor(ss, 16); ss += __shfl_xor(ss, 32);
                    const float rstd = 1.0f / sqrtf(ss * (1.0f / 64.0f) + EPS);
#pragma unroll
                    for (int bj = 0; bj < 2; ++bj)
#pragma unroll
                        for (int n = 0; n < 2; ++n) v[bj][n] = v[bj][n] * rstd * gv[bj][n];
                    if (rope) {
                        const int t = row & (SEQ - 1), gr = t >> 6, gc = t & 63;
                        const f32x4 cr = *(const f32x4*)(ropeC + gr * 16 + 4 * fq), sr = *(const f32x4*)(ropeS + gr * 16 + 4 * fq);
                        const f32x4 cc = *(const f32x4*)(ropeC + gc * 16 + 4 * fq), sc = *(const f32x4*)(ropeS + gc * 16 + 4 * fq);
                        const f32x4 a1 = v[0][0], a2 = v[0][1]; v[0][0] = a1 * cr - a2 * sr; v[0][1] = a2 * cr + a1 * sr;
                        const f32x4 b1 = v[1][0], b2 = v[1][1]; v[1][0] = b1 * cc - b2 * sc; v[1][1] = b2 * cc + b1 * sc;
                    }
#pragma unroll
                    for (int bj = 0; bj < 2; ++bj)
#pragma unroll
                        for (int n = 0; n < 2; ++n) v[bj][n] = v[bj][n] * qs;
                }
                bf16_t* rowp = QKV + (size_t)row * QKVN + pn * BM + wc * 64 + 4 * fq;
#pragma unroll
                for (int bj = 0; bj < 2; ++bj)
#pragma unroll
                    for (int n = 0; n < 2; ++n) { u32x2 w; w.x = cvt_pk_bf16(v[bj][n][0], v[bj][n][1]); w.y = cvt_pk_bf16(v[bj][n][2], v[bj][n][3]); *(u32x2*)(rowp + 32 * bj + 16 * n) = w; }
            }
    }
};
struct EpiGU {
    static constexpr bool PERM = true, AFTER_DRAIN = false;
    bf16_t* H;
    __device__ __forceinline__ void operator()(const f32x4 (&acc)[2][2][4][2], const Unit& u, int wr, int wc, int fr, int fq) const {
#pragma unroll
        for (int ai = 0; ai < 2; ++ai)
#pragma unroll
            for (int m = 0; m < 4; ++m) {
                const int row = u.pm * BM + ai * HALF + wr * 64 + m * 16 + fr;
                float h[8];
#pragma unroll
                for (int n = 0; n < 2; ++n)
#pragma unroll
                    for (int e = 0; e < 4; ++e) { const float g = acc[ai][0][m][n][e], up = acc[ai][1][m][n][e]; h[4 * n + e] = g * __builtin_amdgcn_rcpf(1.0f + __expf(-g)) * up; }
                u32x4 w; w.x = cvt_pk_bf16(h[0], h[1]); w.y = cvt_pk_bf16(h[2], h[3]); w.z = cvt_pk_bf16(h[4], h[5]); w.w = cvt_pk_bf16(h[6], h[7]);
                *(u32x4*)(H + (size_t)row * FF + u.pn * 128 + wc * 32 + 8 * fq) = w;
            }
    }
};
struct EpiRes {
    static constexpr bool PERM = false, AFTER_DRAIN = false;
    const float* src_lat; const float* src_ctx; float* dst_lat; float* dst_ctx; const float* gate;
    __device__ __forceinline__ void operator()(const f32x4 (&acc)[2][2][4][2], const Unit& u, int wr, int wc, int fr, int fq) const {
        const bool lat = u.pm < 64; const int bidx = lat ? (u.pm >> 3) : 8;
        const float* src = lat ? src_lat + (size_t)u.pm * BM * DM : src_ctx + (size_t)(u.pm - 64) * BM * DM;
        float* dst = lat ? dst_lat + (size_t)u.pm * BM * DM : dst_ctx + (size_t)(u.pm - 64) * BM * DM;
        const int col0 = u.pn * BM + wc * 32 + 4 * fq;
        f32x4 gv[2][2];
#pragma unroll
        for (int bj = 0; bj < 2; ++bj)
#pragma unroll
            for (int n = 0; n < 2; ++n) gv[bj][n] = *(const f32x4*)(gate + bidx * 6144 + col0 + bj * HALF + n * 16);
#pragma unroll
        for (int ai = 0; ai < 2; ++ai)
#pragma unroll
            for (int m = 0; m < 4; ++m) {
                const size_t off = (size_t)(ai * HALF + wr * 64 + m * 16 + fr) * DM + col0;
#pragma unroll
                for (int bj = 0; bj < 2; ++bj)
#pragma unroll
                    for (int n = 0; n < 2; ++n) { const f32x4 xs = *(const f32x4*)(src + off + bj * HALF + n * 16); *(f32x4*)(dst + off + bj * HALF + n * 16) = xs + gv[bj][n] * acc[ai][bj][m][n]; }
            }
    }
};
template <class Epi, class Sched, bool ALIGN_EPI = false, bool SP2 = false>
__device__ __forceinline__ void gemm_phase(PG8_LAS unsigned char* lds, const Gemm g, const Sched& S, const Epi& E) {
    int tid_ = threadIdx.x; asm volatile("" : "+v"(tid_));
    const int tid = tid_, wid = __builtin_amdgcn_readfirstlane(tid >> 6), lane = tid & 63, wr = wid >> 2, wc = wid & 3, fr = lane & 15, fq = lane >> 4;
    const int K = g.K, nt = K / BK;
    unsigned voffA[2], voffB[2];
#pragma unroll
    for (int i = 0; i < 2; ++i) { int R, C; stage_rc(tid * 16 + i * 8192, R, C); const int Rb = Epi::PERM ? ((R & ~31) + perm32(R & 31)) : R;
        voffA[i] = (unsigned)(R * K + C) * 2u; voffB[i] = (unsigned)(Rb * K + C) * 2u; }
    const size_t kstep = (size_t)(BK * 2);
    const size_t hstep = (size_t)HALF * K * 2;
    const size_t tstep = 2 * hstep;
    const unsigned ldsw = (unsigned)wid * 1024u;
    const int aoff = lds_byte(wr * 64 + fr, fq * 8), boff = lds_byte(wc * 32 + fr, fq * 8);
#define PG8_SA(b, h) (((b) * 2 + (h)) * HTB)
#define PG8_SB(b, h) ((4 + (b) * 2 + (h)) * HTB)
#define PG8_STAGE(bufoff, gbase, voff) do { _Pragma("unroll") for (int _i = 0; _i < 2; ++_i) \
        __builtin_amdgcn_global_load_lds((const unsigned*)((const char*)(gbase) + (voff)[_i]), (PG8_LAS unsigned*)(lds + (bufoff) + ldsw + _i * 8192), 16, 0, 0); } while (0)
#define PG8_LDA(dst, b, h) do { _Pragma("unroll") for (int m = 0; m < 4; ++m) _Pragma("unroll") for (int k = 0; k < 2; ++k) dst[m][k] = *(const PG8_LAS bf16x8*)(lds + PG8_SA(b, h) + aoff + m * 2048 + k * 1024); } while (0)
#define PG8_LDB(dst, b, h) do { _Pragma("unroll") for (int n = 0; n < 2; ++n) _Pragma("unroll") for (int k = 0; k < 2; ++k) dst[n][k] = *(const PG8_LAS bf16x8*)(lds + PG8_SB(b, h) + boff + n * 2048 + k * 1024); } while (0)
#define PG8_MMA(ai, bj, At, Bt) do { __builtin_amdgcn_s_setprio(1); _Pragma("unroll") for (int m = 0; m < 4; ++m) _Pragma("unroll") for (int n = 0; n < 2; ++n) _Pragma("unroll") for (int k = 0; k < 2; ++k) \
        acc[ai][bj][m][n] = __builtin_amdgcn_mfma_f32_16x16x32_bf16(Bt[n][k], At[m][k], acc[ai][bj][m][n], 0, 0, 0); __builtin_amdgcn_s_setprio(0); } while (0)
#define PG8_WAIT_V(n) asm volatile("s_waitcnt vmcnt(" #n ")" ::: "memory")
#define PG8_WAIT_L(n) asm volatile("s_waitcnt lgkmcnt(" #n ")" ::: "memory")
#define PG8_BAR __builtin_amdgcn_s_barrier()
#define PG8_SCHED __builtin_amdgcn_sched_barrier(0)
    Unit cur, nxt; int ui = 0;
    if (!S.next(0, cur)) return;
    f32x4 acc[2][2][4][2];
#pragma unroll
    for (int a = 0; a < 2; ++a)
#pragma unroll
        for (int b = 0; b < 2; ++b)
#pragma unroll
            for (int m = 0; m < 4; ++m)
#pragma unroll
                for (int n = 0; n < 2; ++n) acc[a][b][m][n] = (f32x4){0.f, 0.f, 0.f, 0.f};
    bf16x8 At[4][2], B0[2][2], B1[2][2];
    const char* cA = (const char*)g.A + (size_t)cur.pm * tstep; const char* cB = (const char*)g.Bt + (size_t)cur.pn * tstep;
    S.a_ready(cur);
    if constexpr (SP2) {
        PG8_STAGE(PG8_SB(0, 0), cB, voffB); PG8_STAGE(PG8_SB(0, 1), cB + hstep, voffB); PG8_STAGE(PG8_SA(0, 0), cA, voffA); PG8_STAGE(PG8_SA(0, 1), cA + hstep, voffA);
        if (wr == 1) PG8_BAR;
        PG8_WAIT_V(2); PG8_BAR;
        PG8_STAGE(PG8_SB(1, 0), cB + kstep, voffB); PG8_STAGE(PG8_SA(1, 0), cA + kstep, voffA); PG8_STAGE(PG8_SB(1, 1), cB + hstep + kstep, voffB);
        PG8_WAIT_V(6); PG8_BAR;
    } else {
        PG8_STAGE(PG8_SB(0, 0), cB, voffB); PG8_STAGE(PG8_SA(0, 0), cA, voffA); PG8_STAGE(PG8_SB(0, 1), cB + hstep, voffB); PG8_STAGE(PG8_SA(0, 1), cA + hstep, voffA);
        if (wr == 1) PG8_BAR;
        PG8_WAIT_V(4); PG8_BAR;
        PG8_STAGE(PG8_SB(1, 0), cB + kstep, voffB); PG8_STAGE(PG8_SA(1, 0), cA + kstep, voffA); PG8_STAGE(PG8_SB(1, 1), cB + hstep + kstep, voffB);
        PG8_WAIT_V(6); PG8_BAR;
    }
    for (;;) {
        const bool has_next = S.next(ui + 1, nxt);
        const char* nA = has_next ? (const char*)g.A + (size_t)nxt.pm * tstep : cA; const char* nB = has_next ? (const char*)g.Bt + (size_t)nxt.pn * tstep : cB;
        for (int t = 0; t < nt; t += 2) {
            const bool last = (t == nt - 2);
            const char* a1 = cA + (size_t)(t + 1) * kstep;
            const char* a2 = last ? nA : cA + (size_t)(t + 2) * kstep; const char* b2 = last ? nB : cB + (size_t)(t + 2) * kstep;
            const char* a3 = a2 + kstep; const char* b3 = b2 + kstep;
            if (last && has_next) S.a_ready(nxt);
            if constexpr (SP2) {
            PG8_LDB(B0, 0, 0); PG8_LDB(B1, 0, 1); PG8_SCHED; PG8_LDA(At, 0, 0); PG8_STAGE(PG8_SA(1, 1), a1 + hstep, voffA);
            PG8_WAIT_V(8); PG8_WAIT_L(0); PG8_BAR; PG8_MMA(0, 0, At, B0); PG8_MMA(0, 1, At, B1); PG8_BAR; PG8_SCHED;
            PG8_LDA(At, 0, 1); PG8_STAGE(PG8_SB(0, 0), b2, voffB); PG8_STAGE(PG8_SB(0, 1), b2 + hstep, voffB); PG8_STAGE(PG8_SA(0, 0), a2, voffA);
            PG8_WAIT_V(8); PG8_WAIT_L(0); PG8_BAR; PG8_MMA(1, 0, At, B0); PG8_MMA(1, 1, At, B1); PG8_BAR; PG8_SCHED;
            PG8_LDB(B0, 1, 0); PG8_LDB(B1, 1, 1); PG8_SCHED; PG8_LDA(At, 1, 0); PG8_STAGE(PG8_SA(0, 1), a2 + hstep, voffA);
            PG8_WAIT_V(8); PG8_WAIT_L(0); PG8_BAR; PG8_MMA(0, 0, At, B0); PG8_MMA(0, 1, At, B1); PG8_BAR; PG8_SCHED;
            PG8_LDA(At, 1, 1); PG8_STAGE(PG8_SB(1, 0), b3, voffB); PG8_STAGE(PG8_SB(1, 1), b3 + hstep, voffB); PG8_STAGE(PG8_SA(1, 0), a3, voffA);
            PG8_WAIT_V(8); PG8_WAIT_L(0); PG8_BAR; PG8_MMA(1, 0, At, B0); PG8_MMA(1, 1, At, B1); PG8_BAR; PG8_SCHED;
            } else {
            PG8_LDB(B0, 0, 0); PG8_SCHED; PG8_LDA(At, 0, 0); PG8_STAGE(PG8_SA(1, 1), a1 + hstep, voffA);
            PG8_WAIT_L(8); PG8_BAR; PG8_WAIT_L(0); PG8_MMA(0, 0, At, B0); PG8_BAR; PG8_SCHED;
            PG8_LDB(B1, 0, 1); PG8_STAGE(PG8_SB(0, 0), b2, voffB);
            PG8_BAR; PG8_WAIT_L(0); PG8_MMA(0, 1, At, B1); PG8_BAR;
            PG8_LDA(At, 0, 1); PG8_STAGE(PG8_SA(0, 0), a2, voffA);
            PG8_BAR; PG8_WAIT_L(0); PG8_MMA(1, 0, At, B0); PG8_BAR; PG8_SCHED;
            PG8_STAGE(PG8_SB(0, 1), b2 + hstep, voffB);
            PG8_WAIT_V(6); PG8_BAR; PG8_MMA(1, 1, At, B1); PG8_BAR;
            PG8_LDB(B0, 1, 0); PG8_SCHED; PG8_LDA(At, 1, 0); PG8_STAGE(PG8_SA(0, 1), a2 + hstep, voffA);
            PG8_WAIT_L(8); PG8_BAR; PG8_WAIT_L(0); PG8_MMA(0, 0, At, B0); PG8_BAR; PG8_SCHED;
            PG8_LDB(B1, 1, 1); PG8_STAGE(PG8_SB(1, 0), b3, voffB);
            PG8_BAR; PG8_WAIT_L(0); PG8_MMA(0, 1, At, B1); PG8_BAR;
            PG8_LDA(At, 1, 1); PG8_STAGE(PG8_SA(1, 0), a3, voffA);
            PG8_BAR; PG8_WAIT_L(0); PG8_MMA(1, 0, At, B0); PG8_BAR; PG8_SCHED;
            PG8_STAGE(PG8_SB(1, 1), b3 + hstep, voffB);
            PG8_WAIT_V(6); PG8_BAR; PG8_MMA(1, 1, At, B1); PG8_BAR;
            }
        }
        if constexpr (ALIGN_EPI) { if (wr == 0) PG8_BAR; }
        if constexpr (!Epi::AFTER_DRAIN) { E(acc, cur, wr, wc, fr, fq); S.done(cur); }
        if (!has_next) break;
#pragma unroll
        for (int a = 0; a < 2; ++a)
#pragma unroll
            for (int b = 0; b < 2; ++b)
#pragma unroll
                for (int m = 0; m < 4; ++m)
#pragma unroll
                    for (int n = 0; n < 2; ++n) acc[a][b][m][n] = (f32x4){0.f, 0.f, 0.f, 0.f};
        cur = nxt; cA = nA; cB = nB; ++ui;
        if constexpr (ALIGN_EPI) { if (wr == 1) PG8_BAR; }
    }
    PG8_WAIT_V(0);
    if constexpr (!ALIGN_EPI) { if (wr == 0) PG8_BAR; }
    PG8_BAR;
    if constexpr (Epi::AFTER_DRAIN) { E.fused(acc, cur, wr, wc, fr, fq, lds, wid, lane); S.done(cur); }
#undef PG8_SA
#undef PG8_SB
#undef PG8_STAGE
#undef PG8_LDA
#undef PG8_LDB
#undef PG8_MMA
#undef PG8_WAIT_V
#undef PG8_WAIT_L
#undef PG8_BAR
#undef PG8_SCHED
}
}
namespace att {
typedef short bf16x8 __attribute__((ext_vector_type(8)));
typedef short s16x4 __attribute__((ext_vector_type(4)));
typedef float f32x16 __attribute__((ext_vector_type(16)));
typedef unsigned u32x4 __attribute__((ext_vector_type(4)));
typedef unsigned short bf16_t;
#define ATT_LAS __attribute__((address_space(3)))
constexpr int LDS_K = 0, LDS_V = 8192, LDS_WS = 16384, LDS_BIAS = 18432, LDS_OST = 20480, LDS_END = LDS_OST + 8 * 4096;
__device__ __forceinline__ int crow(int r, int hi) { return (r & 3) + 8 * (r >> 2) + 4 * hi; }
__device__ __forceinline__ unsigned cvtpk(float lo, float hi) { unsigned r; asm volatile("v_cvt_pk_bf16_f32 %0, %1, %2" : "=v"(r) : "v"(lo), "v"(hi)); return r; }
typedef short v4i16_t __attribute__((ext_vector_type(4)));
__device__ __forceinline__ s16x4 vtr(const ATT_LAS unsigned char* p) { return __builtin_bit_cast(s16x4, __builtin_amdgcn_ds_read_tr16_b64_v4i16((ATT_LAS v4i16_t*)p)); }

struct UnitP { int qrow0, qcol, kcol, vcol, ocol, ctxrow0, latrow0, NT, mode, r0, rlo; const float* rpb; };

__device__ __forceinline__ void make_unit(int u, int layer, const float* rpb_all, UnitP& P) {
    P.r0 = 0; P.rlo = 0; P.rpb = rpb_all; P.mode = 0;
    if (u < 512) { const int b = u >> 6, hq = (u >> 3) & 7, qb = u & 7;
        P.qrow0 = b * SEQ + 256 * qb; P.qcol = 1536 + 64 * hq; P.kcol = 2048 + 64 * (hq >> 2); P.vcol = 2176 + 64 * (hq >> 2); P.ocol = 512 + 64 * hq;
        P.ctxrow0 = NLAT + b * CTXL; P.latrow0 = b * SEQ; P.NT = 36; }
    else if (u < 1024) { const int v = u - 512, b = v >> 6, h = (v >> 3) & 7, g = v & 7;
        P.qrow0 = b * SEQ + 256 * g; P.qcol = 64 * h; P.kcol = 512 + 64 * h; P.vcol = 1024 + 64 * h; P.ocol = 64 * h;
        P.ctxrow0 = NLAT + b * CTXL; P.r0 = 4 * g;
        int rlo = 4 * g - 4; rlo = rlo < 0 ? 0 : (rlo > 24 ? 24 : rlo); int rhs = 4 * g + 3 - 4; rhs = rhs < 0 ? 0 : (rhs > 24 ? 24 : rhs); const int rhi = rhs + 7;
        P.rlo = rlo; P.latrow0 = b * SEQ + 64 * rlo; P.NT = 4 + (rhi - rlo + 1); P.mode = 1; P.rpb = rpb_all + (size_t)(layer * 8 + h) * 15 * 31; }
    else { const int v = u - 1024, b = v >> 4, h16 = v & 15;
        P.qrow0 = NLAT + b * CTXL; P.ctxrow0 = NLAT + b * CTXL; P.latrow0 = 0; P.NT = 4;
        if (h16 < 8) { P.qcol = 64 * h16; P.kcol = 512 + 64 * h16; P.vcol = 1024 + 64 * h16; P.ocol = 64 * h16; }
        else { const int hq = h16 - 8; P.qcol = 1536 + 64 * hq; P.kcol = 2048 + 64 * (hq >> 2); P.vcol = 2176 + 64 * (hq >> 2); P.ocol = 512 + 64 * hq; } }
}

__device__ __forceinline__ void attn_unit(const UnitP& P, const bf16_t* QKV, bf16_t* O, ATT_LAS unsigned char* shm) {
    int tid_ = threadIdx.x; asm volatile("" : "+v"(tid_));
    const int tid = tid_, lane = tid & 63, r32 = lane & 31, hi = lane >> 5; const int wid = __builtin_amdgcn_readfirstlane(tid >> 6);
    ATT_LAS float* wsf = (ATT_LAS float*)(shm + LDS_WS) + wid * 64;
    ATT_LAS float* biasL = (ATT_LAS float*)(shm + LDS_BIAS);
    const bf16_t* Qw = QKV + (size_t)(P.qrow0 + wid * 32 + r32) * QKVN + P.qcol;
    bf16x8 qr[4];
#pragma unroll
    for (int d0 = 0; d0 < 4; ++d0) qr[d0] = *(const bf16x8*)(Qw + d0 * 16 + hi * 8);
    if (P.mode == 1) { for (int i = tid; i < 465; i += 512) biasL[i] = P.rpb[i] * LOG2E; }
    float m = -INFINITY, l = 0.f; f32x16 o[2];
#pragma unroll
    for (int r = 0; r < 16; ++r) { o[0][r] = 0.f; o[1][r] = 0.f; }
    const int qrg = P.r0 + (wid >> 1), qc = 32 * (wid & 1) + r32;
    int rs = qrg - 4; rs = rs < 0 ? 0 : (rs > 24 ? 24 : rs);
    int cs = qc - 8; cs = cs < 0 ? 0 : (cs > 48 ? 48 : cs);
    const ATT_LAS unsigned char* kp = shm + LDS_K + hi * 1024 + r32 * 16;
    const ATT_LAS unsigned char* vp = shm + LDS_V + ((lane >> 4) & 1) * 32 + (lane & 3) * 8 + (4 * hi + ((lane & 15) >> 2)) * 64;
    for (int t = 0; t < P.NT; ++t) {
        const int krow = (t < 4) ? P.ctxrow0 + 64 * t : P.latrow0 + 64 * (t - 4);
        __syncthreads();
        { const u32x4 kv = *(const u32x4*)(QKV + (size_t)(krow + lane) * QKVN + P.kcol + wid * 8);
          const u32x4 vv = *(const u32x4*)(QKV + (size_t)(krow + 16 * (wid & 3) + (lane >> 2)) * QKVN + P.vcol + (wid >> 2) * 32 + (lane & 3) * 8);
          *(ATT_LAS u32x4*)(shm + LDS_K + wid * 1024 + lane * 16) = kv;
          *(ATT_LAS u32x4*)(shm + LDS_V + wid * 1024 + lane * 16) = vv; }
        __syncthreads();
        f32x16 p0, p1;
#pragma unroll
        for (int r = 0; r < 16; ++r) { p0[r] = 0.f; p1[r] = 0.f; }
#pragma unroll
        for (int d0 = 0; d0 < 4; ++d0) {
            const bf16x8 b0 = *(const ATT_LAS bf16x8*)(kp + d0 * 2048), b1 = *(const ATT_LAS bf16x8*)(kp + d0 * 2048 + 512);
            p0 = __builtin_amdgcn_mfma_f32_32x32x16_bf16(b0, qr[d0], p0, 0, 0, 0);
            p1 = __builtin_amdgcn_mfma_f32_32x32x16_bf16(b1, qr[d0], p1, 0, 0, 0);
        }
        if (P.mode == 1 && t >= 4) {
            const int kr = P.rlo + (t - 4); const bool rowok = (kr >= rs) && (kr <= rs + 7);
            int dr = kr - qrg + 7; dr = dr < 0 ? 0 : (dr > 14 ? 14 : dr);
            const ATT_LAS float* brow = biasL + dr * 31;
#pragma unroll
            for (int r = 0; r < 16; ++r) {
                const int k0 = crow(r, hi), k1 = k0 + 32;
                int i0 = k0 - qc + 15; i0 = i0 < 0 ? 0 : (i0 > 30 ? 30 : i0);
                int i1 = k1 - qc + 15; i1 = i1 < 0 ? 0 : (i1 > 30 ? 30 : i1);
                const bool ok0 = rowok && (k0 >= cs) && (k0 <= cs + 15), ok1 = rowok && (k1 >= cs) && (k1 <= cs + 15);
                p0[r] = ok0 ? p0[r] + brow[i0] : -INFINITY;
                p1[r] = ok1 ? p1[r] + brow[i1] : -INFINITY;
            }
        }
        float mx = fmaxf(p0[0], p1[0]);
#pragma unroll
        for (int r = 1; r < 16; ++r) mx = fmaxf(mx, fmaxf(p0[r], p1[r]));
        mx = fmaxf(mx, __shfl_xor(mx, 32));
        const float mn = fmaxf(m, mx); const float alpha = __builtin_amdgcn_exp2f(m - mn); m = mn;
        float s = 0.f;
#pragma unroll
        for (int r = 0; r < 16; ++r) { p0[r] = __builtin_amdgcn_exp2f(p0[r] - mn); p1[r] = __builtin_amdgcn_exp2f(p1[r] - mn); s += p0[r] + p1[r]; }
        l = l * alpha + s;
        if (hi == 0) wsf[r32] = alpha;
#pragma unroll
        for (int r = 0; r < 16; ++r) { const float f = wsf[crow(r, hi)]; o[0][r] *= f; o[1][r] *= f; }
        bf16x8 pa[4];
#pragma unroll
        for (int ks = 0; ks < 4; ++ks) {
            u32x4 w;
            if (ks < 2) { w.x = cvtpk(p0[8 * ks + 0], p0[8 * ks + 1]); w.y = cvtpk(p0[8 * ks + 2], p0[8 * ks + 3]); w.z = cvtpk(p0[8 * ks + 4], p0[8 * ks + 5]); w.w = cvtpk(p0[8 * ks + 6], p0[8 * ks + 7]); }
            else { const int q = ks - 2; w.x = cvtpk(p1[8 * q + 0], p1[8 * q + 1]); w.y = cvtpk(p1[8 * q + 2], p1[8 * q + 3]); w.z = cvtpk(p1[8 * q + 4], p1[8 * q + 5]); w.w = cvtpk(p1[8 * q + 6], p1[8 * q + 7]); }
            pa[ks] = __builtin_bit_cast(bf16x8, w);
        }
#pragma unroll
        for (int d0 = 0; d0 < 2; ++d0)
#pragma unroll
            for (int ks = 0; ks < 4; ++ks) {
                const s16x4 lo = vtr(vp + d0 * 4096 + ks * 1024), h4 = vtr(vp + d0 * 4096 + ks * 1024 + 512);
                const bf16x8 vb = (bf16x8){lo[0], lo[1], lo[2], lo[3], h4[0], h4[1], h4[2], h4[3]};
                o[d0] = __builtin_amdgcn_mfma_f32_32x32x16_bf16(pa[ks], vb, o[d0], 0, 0, 0);
            }
    }
    l += __shfl_xor(l, 32);
    if (hi == 0) wsf[32 + r32] = l;
    ATT_LAS bf16_t* stg = (ATT_LAS bf16_t*)(shm + LDS_OST) + wid * 2048;
#pragma unroll
    for (int r = 0; r < 16; ++r) { const int orow = crow(r, hi); const float rl = 1.0f / wsf[32 + orow];
        const unsigned a = cvtpk(o[0][r] * rl, 0.f), b = cvtpk(o[1][r] * rl, 0.f);
        stg[orow * 64 + r32] = (bf16_t)(a & 0xffffu); stg[orow * 64 + 32 + r32] = (bf16_t)(b & 0xffffu); }
    bf16_t* Ow = O + (size_t)(P.qrow0 + wid * 32) * DM + P.ocol;
#pragma unroll
    for (int i = 0; i < 4; ++i) { const int row = i * 8 + (lane >> 3), ch = lane & 7; const u32x4 v = *(const ATT_LAS u32x4*)(stg + row * 64 + ch * 8); *(u32x4*)(Ow + (size_t)row * DM + ch * 8) = v; }
    __syncthreads();
}
}
#define GAS __attribute__((address_space(1)))
#define LAS __attribute__((address_space(3)))
typedef unsigned short bf16;
typedef unsigned v4u __attribute__((ext_vector_type(4)));
typedef float f32x4 __attribute__((ext_vector_type(4)));
constexpr int NWAVES = 8;
constexpr int LDS_BYTES = 147456;
constexpr size_t MiB = 1u << 20;
constexpr size_t WS_CTL = 0;
constexpr size_t WS_MOD = 1 * MiB;
constexpr size_t WS_ROPE = WS_MOD + 960 * 1024;
constexpr size_t WS_W = 2 * MiB;
constexpr size_t W_IN = 0, W_OUT = (size_t)QKVN * DM * 2, W_GU = W_OUT + (size_t)DM * DM * 2, W_DN = W_GU + (size_t)GUN * DM * 2, W_LAYER = W_DN + (size_t)DM * FF * 2;
static_assert(W_LAYER == 23 * MiB, "weights per layer");
constexpr size_t WS_CTXB = 94 * MiB;
constexpr size_t WS_XN = 102 * MiB;
constexpr size_t WS_QKV = 138 * MiB;
constexpr size_t WS_O = 219 * MiB;
constexpr size_t WS_H = 138 * MiB;
constexpr size_t WS_ADAP = 138 * MiB;
constexpr size_t WS_END = 255 * MiB;
static_assert(WS_W + 4 * W_LAYER <= WS_CTXB && WS_QKV + (size_t)NROWS * QKVN * 2 <= WS_O && WS_O + (size_t)NROWS * DM * 2 <= WS_END && WS_H + (size_t)NROWS * FF * 2 <= WS_END, "ws map");

__device__ __forceinline__ unsigned f2bf(float f) { unsigned u = __builtin_bit_cast(unsigned, f); return (u + 0x7fffu + ((u >> 16) & 1u)) >> 16; }
__device__ __forceinline__ unsigned pk2(float lo, float hi) { return f2bf(lo) | (f2bf(hi) << 16); }
__device__ __forceinline__ float wave_sum(float v) {
#pragma unroll
    for (int o = 1; o < 64; o <<= 1) v += __shfl_xor(v, o);
    return v;
}
__device__ __forceinline__ void transpose_item(const float* W, int K, int N, bf16* WT, int k0, int n0, int drow0, LAS float* scr, int lane) {
#pragma unroll 8
    for (int i = 0; i < 32; ++i) { const int kk = 2 * i + (lane >> 5); scr[kk * 33 + (lane & 31)] = W[(size_t)(k0 + kk) * N + n0 + (lane & 31)]; }
    asm volatile("s_waitcnt lgkmcnt(0)" ::: "memory");
    const int c = lane & 7;
#pragma unroll
    for (int j = 0; j < 4; ++j) { const int n = (lane >> 3) + 8 * j; const LAS float* s = scr + (8 * c) * 33 + n;
        v4u o; o.x = pk2(s[0 * 33], s[1 * 33]); o.y = pk2(s[2 * 33], s[3 * 33]); o.z = pk2(s[4 * 33], s[5 * 33]); o.w = pk2(s[6 * 33], s[7 * 33]);
        *(v4u*)(WT + (size_t)(drow0 + n) * K + k0 + 8 * c) = o; }
    asm volatile("s_waitcnt lgkmcnt(0)" ::: "memory");
}

struct Args { const float* in[18]; float* out; unsigned char* ws; int ph_lo, ph_hi; };
enum { I_X = 0, I_C, I_CTX, I_CCTX, I_WADA, I_BADA, I_ANORM, I_WIN, I_QNA, I_KNA, I_QNB, I_KNB, I_RPB, I_WOUT, I_FNORM, I_WG, I_WU, I_WD };

__device__ __forceinline__ void norm_rows(const float* xlat, const float* xctx, const float* g, const float* modl, int shift_chunk, bf16* XN, int gw, int NGW, int lane) {
    asm volatile("" : "+v"(lane));
    f32x4 gv[4];
#pragma unroll
    for (int j = 0; j < 4; ++j) gv[j] = *((const f32x4*)g + lane + 64 * j);
    for (int row = gw; row < NROWS; row += NGW) {
        const bool lat = row < NLAT; const float* xr = lat ? xlat + (size_t)row * DM : xctx + (size_t)(row - NLAT) * DM;
        const int bidx = lat ? (row >> 11) : 8;
        const float* sh = modl + bidx * 6144 + shift_chunk * 1024; const float* sc = sh + 1024;
        f32x4 v[4]; float ss = 0.f;
#pragma unroll
        for (int j = 0; j < 4; ++j) { v[j] = *((const f32x4*)xr + lane + 64 * j); ss += (v[j][0] * v[j][0] + v[j][1] * v[j][1]) + (v[j][2] * v[j][2] + v[j][3] * v[j][3]); }
        const float rstd = 1.0f / sqrtf(wave_sum(ss) * (1.0f / DM) + EPS);
        unsigned long long* o8 = (unsigned long long*)(XN + (size_t)row * DM) + lane;
#pragma unroll
        for (int j = 0; j < 4; ++j) { const f32x4 s4 = *((const f32x4*)sh + lane + 64 * j), c4 = *((const f32x4*)sc + lane + 64 * j);
            const f32x4 y = (v[j] * rstd * gv[j]) * (c4 + 1.0f) + s4;
            o8[64 * j] = (unsigned long long)pk2(y[0], y[1]) | ((unsigned long long)pk2(y[2], y[3]) << 32); }
    }
}

__global__ void __launch_bounds__(NWAVES * 64, 2) fwd(Args args) {
    extern __shared__ __attribute__((aligned(16))) unsigned char lds_raw[];
    LAS unsigned char* lds = (LAS unsigned char*)lds_raw;
    cg::grid_group grid = cg::this_grid();
    const int tid = threadIdx.x, lane = tid & 63, wave = __builtin_amdgcn_readfirstlane(tid >> 6);
    const int G = gridDim.x, bx = blockIdx.x;
    const int gw = bx * NWAVES + wave, NGW = G * NWAVES;
    unsigned char* ws = args.ws;
    float* MOD = (float*)(ws + WS_MOD); float* ROPEC = (float*)(ws + WS_ROPE); float* ROPES = ROPEC + 1024;
    float* CTXB = (float*)(ws + WS_CTXB); bf16* XN = (bf16*)(ws + WS_XN); bf16* QKV = (bf16*)(ws + WS_QKV); bf16* OB = (bf16*)(ws + WS_O); bf16* HB = (bf16*)(ws + WS_H);
    float* ADAP = (float*)(ws + WS_ADAP);
    float* XOUT = args.out;
#define SEAM() grid.sync()

    {
        LAS float* sl = (LAS float*)lds;
        for (int i = tid; i < 9 * 1024; i += NWAVES * 64) { const float c = (i < 8192) ? args.in[I_C][i] : args.in[I_CCTX][i - 8192]; sl[i] = c * __builtin_amdgcn_rcpf(1.0f + __expf(-c)); }
        __syncthreads();
        for (int it = gw; it < 4 * 96 * 8; it += NGW) {
            const int kc = it & 7, cc = (it >> 3) % 96, l = it / 768;
            const float* W = args.in[I_WADA] + (size_t)l * DM * 6144 + (size_t)(kc * 128) * 6144 + cc * 64 + lane;
            float a[9];
#pragma unroll
            for (int i = 0; i < 9; ++i) a[i] = 0.f;
#pragma unroll 2
            for (int k4 = 0; k4 < 32; ++k4) {
                float w[4];
#pragma unroll
                for (int j = 0; j < 4; ++j) w[j] = W[(size_t)(k4 * 4 + j) * 6144];
#pragma unroll
                for (int i = 0; i < 9; ++i) { const f32x4 s4 = *(const LAS f32x4*)(sl + i * 1024 + kc * 128 + k4 * 4); a[i] += (s4[0] * w[0] + s4[1] * w[1]) + (s4[2] * w[2] + s4[3] * w[3]); }
            }
#pragma unroll
            for (int i = 0; i < 9; ++i) ADAP[((size_t)(kc * 4 + l) * 9 + i) * 6144 + cc * 64 + lane] = a[i];
        }
        LAS float* scr = (LAS float*)(lds + 36864 + wave * 8448);
        constexpr int IT_IN = 16 * 72, IT_OUT = 16 * 32, IT_G = 16 * 88, IT_D = 44 * 32, IT_L = IT_IN + IT_OUT + 2 * IT_G + IT_D;
        for (int it = gw; it < 4 * IT_L; it += NGW) {
            const int l = it / IT_L; int r = it % IT_L;
            bf16* WL = (bf16*)(ws + WS_W + (size_t)l * W_LAYER);
            if (r < IT_IN) { const int kb = r / 72, nb = r % 72, n0 = 32 * nb, cl = n0 & 255;
                const int drow0 = (n0 & ~255) + 128 * ((cl & 63) >> 5) + 32 * (cl >> 6);
                transpose_item(args.in[I_WIN] + (size_t)l * DM * QKVN, DM, QKVN, (bf16*)((unsigned char*)WL + W_IN), 64 * kb, n0, drow0, scr, lane); continue; }
            r -= IT_IN;
            if (r < IT_OUT) { const int kb = r / 32, nb = r % 32;
                transpose_item(args.in[I_WOUT] + (size_t)l * DM * DM, DM, DM, (bf16*)((unsigned char*)WL + W_OUT), 64 * kb, 32 * nb, 32 * nb, scr, lane); continue; }
            r -= IT_OUT;
            if (r < 2 * IT_G) { const int up = r >= IT_G; if (up) r -= IT_G; const int kb = r / 88, nb = r % 88, n0 = 32 * nb;
                const int drow0 = 256 * (n0 >> 7) + 128 * up + (n0 & 127);
                transpose_item(args.in[up ? I_WU : I_WG] + (size_t)l * DM * FF, DM, FF, (bf16*)((unsigned char*)WL + W_GU), 64 * kb, n0, drow0, scr, lane); continue; }
            r -= 2 * IT_G;
            { const int kb = r / 32, nb = r % 32;
                transpose_item(args.in[I_WD] + (size_t)l * FF * DM, FF, DM, (bf16*)((unsigned char*)WL + W_DN), 64 * kb, 32 * nb, 32 * nb, scr, lane); }
        }
        for (int i = gw * 64 + lane; i < NCTX * DM / 4; i += NGW * 64) ((f32x4*)CTXB)[i] = ((const f32x4*)args.in[I_CTX])[i];
        if (bx == 0 && tid < 16) {
            const double cb[16] = {0.5403023058681398, 0.8460091102817079, 0.9504152802551828, 0.9842302344700946, 0.9950041652780258, 0.9984192777926645, 0.9995000416652778, 0.9998418902836144,
                                   0.9999500004166653, 0.9999841886533658, 0.9999950000041666, 0.9999984188615866, 0.9999995000000417, 0.9999998418861211, 0.9999999500000004, 0.9999999841886117};
            const double sb[16] = {0.8414709848078965, 0.5331684399140229, 0.31098359290718575, 0.17689218624615005, 0.09983341664682815, 0.05620449921469249, 0.03161750640243371, 0.01778185687966613,
                                   0.009999833334166664, 0.005623383613960186, 0.0031622723897082477, 0.0017782784728035289, 0.0009999998333333417, 0.0005623412955523594, 0.0003162277607463752, 0.00017782794006665674};
            double c1 = 1.0, s1 = 0.0, cf = 1.0, sf = 0.0;
#pragma unroll
            for (int i = 0; i < 16; ++i) if (i == tid) { cf = cb[i]; sf = sb[i]; }
            for (int p = 0; p < 64; ++p) { ROPEC[p * 16 + tid] = (float)c1; ROPES[p * 16 + tid] = (float)s1; const double cn = c1 * cf - s1 * sf, sn = s1 * cf + c1 * sf; c1 = cn; s1 = sn; }
        }
    }
    SEAM();
    for (int e = gw * 64 + lane; e < 4 * 9 * 6144; e += NGW * 64) {
        const int n = e % 6144, li = e / 6144, l = li / 9;
        float s = args.in[I_BADA][l * 6144 + n];
#pragma unroll
        for (int kc = 0; kc < 8; ++kc) s += ADAP[(size_t)kc * 4 * 9 * 6144 + e];
        MOD[e] = s;
    }
    SEAM();

    for (int l = 0; l < DEPTH; ++l) {
        const float* modl = MOD + (size_t)l * 9 * 6144;
        const float* xsrc = (l == 0) ? args.in[I_X] : XOUT;
        const bf16* WL = (const bf16*)(ws + WS_W + (size_t)l * W_LAYER);
        norm_rows(xsrc, CTXB, args.in[I_ANORM] + l * DM, modl, 0, XN, gw, NGW, lane);
        SEAM();
        { pg8::Gemm g{XN, (const bf16*)((const unsigned char*)WL + W_IN), NROWS, QKVN, DM}; pg8::StaticOrder S; S.init(NROWS, QKVN, G, bx);
          pg8::EpiQKV E{QKV, args.in[I_QNA] + l * HD, args.in[I_KNA] + l * HD, args.in[I_QNB] + l * HD, args.in[I_KNB] + l * HD, ROPEC, ROPES};
          pg8::gemm_phase<pg8::EpiQKV, pg8::StaticOrder, true, true>(lds, g, S, E); }
        SEAM();
        { const int nunits = 1152;
          for (int u = bx; u < nunits; u += G) { att::UnitP P; att::make_unit(u, l, args.in[I_RPB], P); att::attn_unit(P, QKV, OB, lds); } }
        SEAM();
        { pg8::Gemm g{OB, (const bf16*)((const unsigned char*)WL + W_OUT), NROWS, DM, DM}; pg8::StaticOrder S; S.init(NROWS, DM, G, bx);
          pg8::EpiRes E{xsrc, CTXB, XOUT, CTXB, modl + 2 * 1024};
          pg8::gemm_phase<pg8::EpiRes, pg8::StaticOrder, true, true>(lds, g, S, E); }
        SEAM();
        norm_rows(XOUT, CTXB, args.in[I_FNORM] + l * DM, modl, 3, XN, gw, NGW, lane);
        SEAM();
        { pg8::Gemm g{XN, (const bf16*)((const unsigned char*)WL + W_GU), NROWS, GUN, DM}; pg8::StaticOrder S; S.init(NROWS, GUN, G, bx);
          pg8::EpiGU E{HB};
          pg8::gemm_phase<pg8::EpiGU, pg8::StaticOrder, true, true>(lds, g, S, E); }
        SEAM();
        { pg8::Gemm g{HB, (const bf16*)((const unsigned char*)WL + W_DN), NROWS, DM, FF}; pg8::StaticOrder S; S.init(NROWS, DM, G, bx);
          pg8::EpiRes E{XOUT, CTXB, XOUT, CTXB, modl + 5 * 1024};
          pg8::gemm_phase<pg8::EpiRes, pg8::StaticOrder, true, true>(lds, g, S, E); }
        SEAM();
    }
}

extern "C" void kernel_launch(void* const* d_in, const int* in_sizes, int n_in, void* d_out, int out_size, void* d_ws, size_t ws_size, hipStream_t stream) {
    static int grid = 0;
    if (grid == 0) {
        if (n_in != 18 || ws_size < WS_END) { fprintf(stderr, "kernel_launch: unexpected n_in %d / ws_size %zu\n", n_in, ws_size); grid = -1; return; }
        int dev = 0, cus = 0, per_cu = 0;
        hipGetDevice(&dev); hipDeviceGetAttribute(&cus, hipDeviceAttributeMultiprocessorCount, dev);
        hipFuncSetAttribute((const void*)fwd, hipFuncAttributeMaxDynamicSharedMemorySize, LDS_BYTES);
        hipOccupancyMaxActiveBlocksPerMultiprocessor(&per_cu, (const void*)fwd, NWAVES * 64, LDS_BYTES);
        if (per_cu < 1) { fprintf(stderr, "kernel_launch: occupancy query says %d blocks per CU\n", per_cu); per_cu = 1; }
        (void)hipGetLastError();
        grid = cus;
    }
    if (grid < 0) return;
    Args a{};
    for (int i = 0; i < 18; ++i) a.in[i] = (const float*)d_in[i];
    a.out = (float*)d_out; a.ws = (unsigned char*)d_ws; a.ph_lo = 0; a.ph_hi = 0;
    void* kargs[] = {&a};
    hipError_t e = hipLaunchCooperativeKernel((const void*)fwd, dim3(grid), dim3(NWAVES * 64), kargs, LDS_BYTES, stream);
    if (e != hipSuccess) fprintf(stderr, "cooperative launch failed: %s (grid %d)\n", hipGetErrorString(e), grid);
}
```

```cpp
#include <hip/hip_runtime.h>
#include <hip/hip_cooperative_groups.h>
#include <hip/hip_bf16.h>
#include <cstdio>
#include <cstdint>
namespace cg = cooperative_groups;

constexpr int NB = 8, SEQ = 2048, DM = 1024, DEPTH = 4, CTXL = 256, HD = 64;
constexpr int NLAT = NB * SEQ;
constexpr int NCTX = NB * CTXL;
constexpr int NROWS = NLAT + NCTX;
constexpr int QKVN = 2304, FF = 2816, GUN = 2 * FF;
constexpr float EPS = 1e-6f;
constexpr float LOG2E = 1.4426950408889634f;
constexpr float C2 = 0.125f * LOG2E;
namespace pg8 {
#define PG8_LAS __attribute__((address_space(3)))
typedef unsigned short bf16_t;
typedef short bf16x8 __attribute__((ext_vector_type(8)));
typedef float f32x4 __attribute__((ext_vector_type(4)));
typedef unsigned u32x4 __attribute__((ext_vector_type(4)));
constexpr int BM = 256, BK = 64, HALF = 128, HTB = HALF * BK * 2  , STAGE_BYTES = 8 * HTB, NXCD = 8, WGM = 8;

__host__ __device__ __forceinline__ int lds_byte(int r, int c) { const int st = (r >> 4) * 2 + (c >> 5), rr = r & 15, cc = c & 31, ob = rr * 64 + cc * 2; return st * 1024 + (ob ^ (((ob >> 9) & 1) << 5)); }
__host__ __device__ __forceinline__ void stage_rc(int b, int& R, int& C) { const int st = b / 1024, sb = b % 1024, swz = sb ^ (((sb >> 9) & 1) << 5); R = (st >> 1) * 16 + swz / 64; C = (st & 1) * 32 + (swz % 64) / 2; }
__host__ __device__ __forceinline__ int perm32(int rho) { const int n = rho >> 4, i = rho & 15; return 8 * (i >> 2) + 4 * n + (i & 3); }

struct Unit { int pm, pn; };
struct Gemm { const bf16_t* A; const bf16_t* Bt; int M, N, K; };

struct StaticOrder {
    int nM, nN, nwg, G, c;
    __host__ __device__ void init(int M, int N, int G_, int c_) { nM = M / BM; nN = N / BM; nwg = nM * nN; G = G_; c = c_; }
    __host__ __device__ bool next(int i, Unit& u) const {
        const long L = (long)i * G + c; if (L >= nwg) return false;
        int wgid = (int)L; { const int q = nwg / NXCD, r = nwg % NXCD, xcd = wgid % NXCD, off = wgid / NXCD; wgid = (xcd < r ? xcd * (q + 1) : r * (q + 1) + (xcd - r) * q) + off; }
        const int nig = WGM * nN, gid = wgid / nig, fm = gid * WGM, gsz = (nM - fm) < WGM ? (nM - fm) : WGM;
        u.pm = fm + ((wgid % nig) % gsz); u.pn = (wgid % nig) / gsz; return true;
    }
    __device__ __forceinline__ void a_ready(const Unit&) const {}
    __device__ __forceinline__ void done(const Unit&) const {}
};

__device__ __forceinline__ unsigned cvt_pk_bf16(float lo, float hi) { unsigned r; asm volatile("v_cvt_pk_bf16_f32 %0, %1, %2" : "=v"(r) : "v"(lo), "v"(hi)); return r; }
typedef unsigned u32x2 __attribute__((ext_vector_type(2)));

struct EpiQKV {
    static constexpr bool PERM = false, AFTER_DRAIN = false;
    bf16_t* QKV; const float* qn_a; const float* kn_a; const float* qn_b; const float* kn_b; const float* ropeC; const float* ropeS;
    __device__ __forceinline__ void operator()(const f32x4 (&acc)[2][2][4][2], const Unit& u, int wr, int wc, int fr, int fq) const {
        const int pn = u.pn;
        int kind; bool rope; const float* gain;
        if (pn < 2) { kind = 0; gain = qn_a; rope = false; }
        else if (pn < 4) { kind = 1; gain = kn_a; rope = false; }
        else if (pn < 6) { kind = 2; gain = qn_a; rope = false; }
        else if (pn < 8) { kind = 0; gain = qn_b; rope = true; }
        else if (wc < 2) { kind = 1; gain = kn_b; rope = true; }
        else { kind = 2; gain = kn_b; rope = false; }
        rope = rope && (u.pm < 64);
        f32x4 gv[2][2];
#pragma unroll
        for (int bj = 0; bj < 2; ++bj)
#pragma unroll
            for (int n = 0; n < 2; ++n) gv[bj][n] = *(const f32x4*)(gain + 32 * bj + 16 * n + 4 * fq);
        const float qs = (kind == 0) ? C2 : 1.f;
#pragma unroll
        for (int ai = 0; ai < 2; ++ai)
#pragma unroll
            for (int m = 0; m < 4; ++m) {
                const int row = u.pm * BM + ai * HALF + wr * 64 + m * 16 + fr;
                f32x4 v[2][2];
#pragma unroll
                for (int bj = 0; bj < 2; ++bj)
#pragma unroll
                    for (int n = 0; n < 2; ++n) v[bj][n] = acc[ai][bj][m][n];
                if (kind != 2) {
                    float ss = 0.f;
#pragma unroll
                    for (int bj = 0; bj < 2; ++bj)
#pragma unroll
                        for (int n = 0; n < 2; ++n) { const f32x4 x = v[bj][n]; ss += (x[0] * x[0] + x[1] * x[1]) + (x[2] * x[2] + x[3] * x[3]); }
                    ss += __shfl_xor(ss, 16); ss += __shfl_xor(ss, 32);
                    const float rstd = 1.0f / sqrtf(ss * (1.0f / 64.0f) + EPS);
#pragma unroll
                    for (int bj = 0; bj < 2; ++bj)
#pragma unroll
                        for (int n = 0; n < 2; ++n) v[bj][n] = v[bj][n] * rstd * gv[bj][n];
                    if (rope) {
                        const int t = row & (SEQ - 1), gr = t >> 6, gc = t & 63;
                        const f32x4 cr = *(const f32x4*)(ropeC + gr * 16 + 4 * fq), sr = *(const f32x4*)(ropeS + gr * 16 + 4 * fq);
                        const f32x4 cc = *(const f32x4*)(ropeC + gc * 16 + 4 * fq), sc = *(const f32x4*)(ropeS + gc * 16 + 4 * fq);
                        const f32x4 a1 = v[0][0], a2 = v[0][1]; v[0][0] = a1 * cr - a2 * sr; v[0][1] = a2 * cr + a1 * sr;
                        const f32x4 b1 = v[1][0], b2 = v[1][1]; v[1][0] = b1 * cc - b2 * sc; v[1][1] = b2 * cc + b1 * sc;
                    }
#pragma unroll
                    for (int bj = 0; bj < 2; ++bj)
#pragma unroll
                        for (int n = 0; n < 2; ++n) v[bj][n] = v[bj][n] * qs;
                }
                bf16_t* rowp = QKV + (size_t)row * QKVN + pn * BM + wc * 64 + 4 * fq;
#pragma unroll
                for (int bj = 0; bj < 2; ++bj)
#pragma unroll
                    for (int n = 0; n < 2; ++n) { u32x2 w; w.x = cvt_pk_bf16(v[bj][n][0], v[bj][n][1]); w.y = cvt_pk_bf16(v[bj][n][2], v[bj][n][3]); *(u32x2*)(rowp + 32 * bj + 16 * n) = w; }
            }
    }
};
struct EpiGU {
    static constexpr bool PERM = true, AFTER_DRAIN = false;
    bf16_t* H;
    __device__ __forceinline__ void operator()(const f32x4 (&acc)[2][2][4][2], const Unit& u, int wr, int wc, int fr, int fq) const {
#pragma unroll
        for (int ai = 0; ai < 2; ++ai)
#pragma unroll
            for (int m = 0; m < 4; ++m) {
                const int row = u.pm * BM + ai * HALF + wr * 64 + m * 16 + fr;
                float h[8];
#pragma unroll
                for (int n = 0; n < 2; ++n)
#pragma unroll
                    for (int e = 0; e < 4; ++e) { const float g = acc[ai][0][m][n][e], up = acc[ai][1][m][n][e]; h[4 * n + e] = g * __builtin_amdgcn_rcpf(1.0f + __expf(-g)) * up; }
                u32x4 w; w.x = cvt_pk_bf16(h[0], h[1]); w.y = cvt_pk_bf16(h[2], h[3]); w.z = cvt_pk_bf16(h[4], h[5]); w.w = cvt_pk_bf16(h[6], h[7]);
                *(u32x4*)(H + (size_t)row * FF + u.pn * 128 + wc * 32 + 8 * fq) = w;
            }
    }
};
struct EpiRes {
    static constexpr bool PERM = false, AFTER_DRAIN = false;
    const float* src_lat; const float* src_ctx; float* dst_lat; float* dst_ctx; const float* gate;
    __device__ __forceinline__ void operator()(const f32x4 (&acc)[2][2][4][2], const Unit& u, int wr, int wc, int fr, int fq) const {
        const bool lat = u.pm < 64; const int bidx = lat ? (u.pm >> 3) : 8;
        const float* src = lat ? src_lat + (size_t)u.pm * BM * DM : src_ctx + (size_t)(u.pm - 64) * BM * DM;
        float* dst = lat ? dst_lat + (size_t)u.pm * BM * DM : dst_ctx + (size_t)(u.pm - 64) * BM * DM;
        const int col0 = u.pn * BM + wc * 32 + 4 * fq;
        f32x4 gv[2][2];
#pragma unroll
        for (int bj = 0; bj < 2; ++bj)
#pragma unroll
            for (int n = 0; n < 2; ++n) gv[bj][n] = *(const f32x4*)(gate + bidx * 6144 + col0 + bj * HALF + n * 16);
#pragma unroll
        for (int ai = 0; ai < 2; ++ai)
#pragma unroll
            for (int m = 0; m < 4; ++m) {
                const size_t off = (size_t)(ai * HALF + wr * 64 + m * 16 + fr) * DM + col0;
#pragma unroll
                for (int bj = 0; bj < 2; ++bj)
#pragma unroll
                    for (int n = 0; n < 2; ++n) { const f32x4 xs = *(const f32x4*)(src + off + bj * HALF + n * 16); *(f32x4*)(dst + off + bj * HALF + n * 16) = xs + gv[bj][n] * acc[ai][bj][m][n]; }
            }
    }
};
template <class Epi, class Sched, bool ALIGN_EPI = false, bool SP2 = false>
__device__ __forceinline__ void gemm_phase(PG8_LAS unsigned char* lds, const Gemm g, const Sched& S, const Epi& E) {
    int tid_ = threadIdx.x; asm volatile("" : "+v"(tid_));
    const int tid = tid_, wid = __builtin_amdgcn_readfirstlane(tid >> 6), lane = tid & 63, wr = wid >> 2, wc = wid & 3, fr = lane & 15, fq = lane >> 4;
    const int K = g.K, nt = K / BK;
    unsigned voffA[2], voffB[2];
#pragma unroll
    for (int i = 0; i < 2; ++i) { int R, C; stage_rc(tid * 16 + i * 8192, R, C); const int Rb = Epi::PERM ? ((R & ~31) + perm32(R & 31)) : R;
        voffA[i] = (unsigned)(R * K + C) * 2u; voffB[i] = (unsigned)(Rb * K + C) * 2u; }
    const size_t kstep = (size_t)(BK * 2);
    const size_t hstep = (size_t)HALF * K * 2;
    const size_t tstep = 2 * hstep;
    const unsigned ldsw = (unsigned)wid * 1024u;
    const int aoff = lds_byte(wr * 64 + fr, fq * 8), boff = lds_byte(wc * 32 + fr, fq * 8);
#define PG8_SA(b, h) (((b) * 2 + (h)) * HTB)
#define PG8_SB(b, h) ((4 + (b) * 2 + (h)) * HTB)
#define PG8_STAGE(bufoff, gbase, voff) do { _Pragma("unroll") for (int _i = 0; _i < 2; ++_i) \
        __builtin_amdgcn_global_load_lds((const unsigned*)((const char*)(gbase) + (voff)[_i]), (PG8_LAS unsigned*)(lds + (bufoff) + ldsw + _i * 8192), 16, 0, 0); } while (0)
#define PG8_LDA(dst, b, h) do { _Pragma("unroll") for (int m = 0; m < 4; ++m) _Pragma("unroll") for (int k = 0; k < 2; ++k) dst[m][k] = *(const PG8_LAS bf16x8*)(lds + PG8_SA(b, h) + aoff + m * 2048 + k * 1024); } while (0)
#define PG8_LDB(dst, b, h) do { _Pragma("unroll") for (int n = 0; n < 2; ++n) _Pragma("unroll") for (int k = 0; k < 2; ++k) dst[n][k] = *(const PG8_LAS bf16x8*)(lds + PG8_SB(b, h) + boff + n * 2048 + k * 1024); } while (0)
#define PG8_MMA(ai, bj, At, Bt) do { __builtin_amdgcn_s_setprio(1); _Pragma("unroll") for (int m = 0; m < 4; ++m) _Pragma("unroll") for (int n = 0; n < 2; ++n) _Pragma("unroll") for (int k = 0; k < 2; ++k) \
        acc[ai][bj][m][n] = __builtin_amdgcn_mfma_f32_16x16x32_bf16(Bt[n][k], At[m][k], acc[ai][bj][m][n], 0, 0, 0); __builtin_amdgcn_s_setprio(0); } while (0)
#define PG8_WAIT_V(n) asm volatile("s_waitcnt vmcnt(" #n ")" ::: "memory")
#define PG8_WAIT_L(n) asm volatile("s_waitcnt lgkmcnt(" #n ")" ::: "memory")
#define PG8_BAR __builtin_amdgcn_s_barrier()
#define PG8_SCHED __builtin_amdgcn_sched_barrier(0)
    Unit cur, nxt; int ui = 0;
    if (!S.next(0, cur)) return;
    f32x4 acc[2][2][4][2];
#pragma unroll
    for (int a = 0; a < 2; ++a)
#pragma unroll
        for (int b = 0; b < 2; ++b)
#pragma unroll
            for (int m = 0; m < 4; ++m)
#pragma unroll
                for (int n = 0; n < 2; ++n) acc[a][b][m][n] = (f32x4){0.f, 0.f, 0.f, 0.f};
    bf16x8 At[4][2], B0[2][2], B1[2][2];
    const char* cA = (const char*)g.A + (size_t)cur.pm * tstep; const char* cB = (const char*)g.Bt + (size_t)cur.pn * tstep;
    S.a_ready(cur);
    if constexpr (SP2) {
        PG8_STAGE(PG8_SB(0, 0), cB, voffB); PG8_STAGE(PG8_SB(0, 1), cB + hstep, voffB); PG8_STAGE(PG8_SA(0, 0), cA, voffA); PG8_STAGE(PG8_SA(0, 1), cA + hstep, voffA);
        if (wr == 1) PG8_BAR;
        PG8_WAIT_V(2); PG8_BAR;
        PG8_STAGE(PG8_SB(1, 0), cB + kstep, voffB); PG8_STAGE(PG8_SA(1, 0), cA + kstep, voffA); PG8_STAGE(PG8_SB(1, 1), cB + hstep + kstep, voffB);
        PG8_WAIT_V(6); PG8_BAR;
    } else {
        PG8_STAGE(PG8_SB(0, 0), cB, voffB); PG8_STAGE(PG8_SA(0, 0), cA, voffA); PG8_STAGE(PG8_SB(0, 1), cB + hstep, voffB); PG8_STAGE(PG8_SA(0, 1), cA + hstep, voffA);
        if (wr == 1) PG8_BAR;
        PG8_WAIT_V(4); PG8_BAR;
        PG8_STAGE(PG8_SB(1, 0), cB + kstep, voffB); PG8_STAGE(PG8_SA(1, 0), cA + kstep, voffA); PG8_STAGE(PG8_SB(1, 1), cB + hstep + kstep, voffB);
        PG8_WAIT_V(6); PG8_BAR;
    }
    for (;;) {
        const bool has_next = S.next(ui + 1, nxt);
        const char* nA = has_next ? (const char*)g.A + (size_t)nxt.pm * tstep : cA; const char* nB = has_next ? (const char*)g.Bt + (size_t)nxt.pn * tstep : cB;
        for (int t = 0; t < nt; t += 2) {
            const bool last = (t == nt - 2);
            const char* a1 = cA + (size_t)(t + 1) * kstep;
            const char* a2 = last ? nA : cA + (size_t)(t + 2) * kstep; const char* b2 = last ? nB : cB + (size_t)(t + 2) * kstep;
            const char* a3 = a2 + kstep; const char* b3 = b2 + kstep;
            if (last && has_next) S.a_ready(nxt);
            if constexpr (SP2) {
            PG8_LDB(B0, 0, 0); PG8_LDB(B1, 0, 1); PG8_SCHED; PG8_LDA(At, 0, 0); PG8_STAGE(PG8_SA(1, 1), a1 + hstep, voffA);
            PG8_WAIT_V(8); PG8_WAIT_L(0); PG8_BAR; PG8_MMA(0, 0, At, B0); PG8_MMA(0, 1, At, B1); PG8_BAR; PG8_SCHED;
            PG8_LDA(At, 0, 1); PG8_STAGE(PG8_SB(0, 0), b2, voffB); PG8_STAGE(PG8_SB(0, 1), b2 + hstep, voffB); PG8_STAGE(PG8_SA(0, 0), a2, voffA);
            PG8_WAIT_V(8); PG8_WAIT_L(0); PG8_BAR; PG8_MMA(1, 0, At, B0); PG8_MMA(1, 1, At, B1); PG8_BAR; PG8_SCHED;
            PG8_LDB(B0, 1, 0); PG8_LDB(B1, 1, 1); PG8_SCHED; PG8_LDA(At, 1, 0); PG8_STAGE(PG8_SA(0, 1), a2 + hstep, voffA);
            PG8_WAIT_V(8); PG8_WAIT_L(0); PG8_BAR; PG8_MMA(0, 0, At, B0); PG8_MMA(0, 1, At, B1); PG8_BAR; PG8_SCHED;
            PG8_LDA(At, 1, 1); PG8_STAGE(PG8_SB(1, 0), b3, voffB); PG8_STAGE(PG8_SB(1, 1), b3 + hstep, voffB); PG8_STAGE(PG8_SA(1, 0), a3, voffA);
            PG8_WAIT_V(8); PG8_WAIT_L(0); PG8_BAR; PG8_MMA(1, 0, At, B0); PG8_MMA(1, 1, At, B1); PG8_BAR; PG8_SCHED;
            } else {
            PG8_LDB(B0, 0, 0); PG8_SCHED; PG8_LDA(At, 0, 0); PG8_STAGE(PG8_SA(1, 1), a1 + hstep, voffA);
            PG8_WAIT_L(8); PG8_BAR; PG8_WAIT_L(0); PG8_MMA(0, 0, At, B0); PG8_BAR; PG8_SCHED;
            PG8_LDB(B1, 0, 1); PG8_STAGE(PG8_SB(0, 0), b2, voffB);
            PG8_BAR; PG8_WAIT_L(0); PG8_MMA(0, 1, At, B1); PG8_BAR;
            PG8_LDA(At, 0, 1); PG8_STAGE(PG8_SA(0, 0), a2, voffA);
            PG8_BAR; PG8_WAIT_L(0); PG8_MMA(1, 0, At, B0); PG8_BAR; PG8_SCHED;
            PG8_STAGE(PG8_SB(0, 1), b2 + hstep, voffB);
            PG8_WAIT_V(6); PG8_BAR; PG8_MMA(1, 1, At, B1); PG8_BAR;
            PG8_LDB(B0, 1, 0); PG8_SCHED; PG8_LDA(At, 1, 0); PG8_STAGE(PG8_SA(0, 1), a2 + hstep, voffA);
            PG8_WAIT_L(8); PG8_BAR; PG8_WAIT_L(0); PG8_MMA(0, 0, At, B0); PG8_BAR; PG8_SCHED;
            PG8_LDB(B1, 1, 1); PG8_STAGE(PG8_SB(1, 0), b3, voffB);
            PG8_BAR; PG8_WAIT_L(0); PG8_MMA(0, 1, At, B1); PG8_BAR;
            PG8_LDA(At, 1, 1); PG8_STAGE(PG8_SA(1, 0), a3, voffA);
            PG8_BAR; PG8_WAIT_L(0); PG8_MMA(1, 0, At, B0); PG8_BAR; PG8_SCHED;
            PG8_STAGE(PG8_SB(1, 1), b3 + hstep, voffB);
            PG8_WAIT_V(6); PG8_BAR; PG8_MMA(1, 1, At, B1); PG8_BAR;
            }
        }
        if constexpr (ALIGN_EPI) { if (wr == 0) PG8_BAR; }
        if constexpr (!Epi::AFTER_DRAIN) { E(acc, cur, wr, wc, fr, fq); S.done(cur); }
        if (!has_next) break;
#pragma unroll
        for (int a = 0; a < 2; ++a)
#pragma unroll
            for (int b = 0; b < 2; ++b)
#pragma unroll
                for (int m = 0; m < 4; ++m)
#pragma unroll
                    for (int n = 0; n < 2; ++n) acc[a][b][m][n] = (f32x4){0.f, 0.f, 0.f, 0.f};
        cur = nxt; cA = nA; cB = nB; ++ui;
        if constexpr (ALIGN_EPI) { if (wr == 1) PG8_BAR; }
    }
    PG8_WAIT_V(0);
    if constexpr (!ALIGN_EPI) { if (wr == 0) PG8_BAR; }
    PG8_BAR;
    if constexpr (Epi::AFTER_DRAIN) { E.fused(acc, cur, wr, wc, fr, fq, lds, wid, lane); S.done(cur); }
#undef PG8_SA
#undef PG8_SB
#undef PG8_STAGE
#undef PG8_LDA
#undef PG8_LDB
#undef PG8_MMA
#undef PG8_WAIT_V
#undef PG8_WAIT_L
#undef PG8_BAR
#undef PG8_SCHED
}
}
namespace att {
typedef short bf16x8 __attribute__((ext_vector_type(8)));
typedef short s16x4 __attribute__((ext_vector_type(4)));
typedef float f32x16 __attribute__((ext_vector_type(16)));
typedef unsigned u32x4 __attribute__((ext_vector_type(4)));
typedef unsigned short bf16_t;
#define ATT_LAS __attribute__((address_space(3)))
constexpr int LDS_K = 0, LDS_V = 8192, LDS_WS = 16384, LDS_BIAS = 18432, LDS_OST = 20480, LDS_END = LDS_OST + 8 * 4096;
__device__ __forceinline__ int crow(int r, int hi) { return (r & 3) + 8 * (r >> 2) + 4 * hi; }
__device__ __forceinline__ unsigned cvtpk(float lo, float hi) { unsigned r; asm volatile("v_cvt_pk_bf16_f32 %0, %1, %2" : "=v"(r) : "v"(lo), "v"(hi)); return r; }
typedef short v4i16_t __attribute__((ext_vector_type(4)));
__device__ __forceinline__ s16x4 vtr(const ATT_LAS unsigned char* p) { return __builtin_bit_cast(s16x4, __builtin_amdgcn_ds_read_tr16_b64_v4i16((ATT_LAS v4i16_t*)p)); }

struct UnitP { int qrow0, qcol, kcol, vcol, ocol, ctxrow0, latrow0, NT, mode, r0, rlo; const float* rpb; };

__device__ __forceinline__ void make_unit(int u, int layer, const float* rpb_all, UnitP& P) {
    P.r0 = 0; P.rlo = 0; P.rpb = rpb_all; P.mode = 0;
    if (u < 512) { const int b = u >> 6, hq = (u >> 3) & 7, qb = u & 7;
        P.qrow0 = b * SEQ + 256 * qb; P.qcol = 1536 + 64 * hq; P.kcol = 2048 + 64 * (hq >> 2); P.vcol = 2176 + 64 * (hq >> 2); P.ocol = 512 + 64 * hq;
        P.ctxrow0 = NLAT + b * CTXL; P.latrow0 = b * SEQ; P.NT = 36; }
    else if (u < 1024) { const int v = u - 512, b = v >> 6, h = (v >> 3) & 7, g = v & 7;
        P.qrow0 = b * SEQ + 256 * g; P.qcol = 64 * h; P.kcol = 512 + 64 * h; P.vcol = 1024 + 64 * h; P.ocol = 64 * h;
        P.ctxrow0 = NLAT + b * CTXL; P.r0 = 4 * g;
        int rlo = 4 * g - 4; rlo = rlo < 0 ? 0 : (rlo > 24 ? 24 : rlo); int rhs = 4 * g + 3 - 4; rhs = rhs < 0 ? 0 : (rhs > 24 ? 24 : rhs); const int rhi = rhs + 7;
        P.rlo = rlo; P.latrow0 = b * SEQ + 64 * rlo; P.NT = 4 + (rhi - rlo + 1); P.mode = 1; P.rpb = rpb_all + (size_t)(layer * 8 + h) * 15 * 31; }
    else { const int v = u - 1024, b = v >> 4, h16 = v & 15;
        P.qrow0 = NLAT + b * CTXL; P.ctxrow0 = NLAT + b * CTXL; P.latrow0 = 0; P.NT = 4;
        if (h16 < 8) { P.qcol = 64 * h16; P.kcol = 512 + 64 * h16; P.vcol = 1024 + 64 * h16; P.ocol = 64 * h16; }
        else { const int hq = h16 - 8; P.qcol = 1536 + 64 * hq; P.kcol = 2048 + 64 * (hq >> 2); P.vcol = 2176 + 64 * (hq >> 2); P.ocol = 512 + 64 * hq; } }
}

__device__ __forceinline__ void attn_unit(const UnitP& P, const bf16_t* QKV, bf16_t* O, ATT_LAS unsigned char* shm) {
    int tid_ = threadIdx.x; asm volatile("" : "+v"(tid_));
    const int tid = tid_, lane = tid & 63, r32 = lane & 31, hi = lane >> 5; const int wid = __builtin_amdgcn_readfirstlane(tid >> 6);
    ATT_LAS float* wsf = (ATT_LAS float*)(shm + LDS_WS) + wid * 64;
    ATT_LAS float* biasL = (ATT_LAS float*)(shm + LDS_BIAS);
    const bf16_t* Qw = QKV + (size_t)(P.qrow0 + wid * 32 + r32) * QKVN + P.qcol;
    bf16x8 qr[4];
#pragma unroll
    for (int d0 = 0; d0 < 4; ++d0) qr[d0] = *(const bf16x8*)(Qw + d0 * 16 + hi * 8);
    if (P.mode == 1) { for (int i = tid; i < 465; i += 512) biasL[i] = P.rpb[i] * LOG2E; }
    float m = -INFINITY, l = 0.f; f32x16 o[2];
#pragma unroll
    for (int r = 0; r < 16; ++r) { o[0][r] = 0.f; o[1][r] = 0.f; }
    const int qrg = P.r0 + (wid >> 1), qc = 32 * (wid & 1) + r32;
    int rs = qrg - 4; rs = rs < 0 ? 0 : (rs > 24 ? 24 : rs);
    int cs = qc - 8; cs = cs < 0 ? 0 : (cs > 48 ? 48 : cs);
    const ATT_LAS unsigned char* kp = shm + LDS_K + hi * 1024 + r32 * 16;
    const ATT_LAS unsigned char* vp = shm + LDS_V + ((lane >> 4) & 1) * 32 + (lane & 3) * 8 + (4 * hi + ((lane & 15) >> 2)) * 64;
    for (int t = 0; t < P.NT; ++t) {
        const int krow = (t < 4) ? P.ctxrow0 + 64 * t : P.latrow0 + 64 * (t - 4);
        __syncthreads();
        { const u32x4 kv = *(const u32x4*)(QKV + (size_t)(krow + lane) * QKVN + P.kcol + wid * 8);
          const u32x4 vv = *(const u32x4*)(QKV + (size_t)(krow + 16 * (wid & 3) + (lane >> 2)) * QKVN + P.vcol + (wid >> 2) * 32 + (lane & 3) * 8);
          *(ATT_LAS u32x4*)(shm + LDS_K + wid * 1024 + lane * 16) = kv;
          *(ATT_LAS u32x4*)(shm + LDS_V + wid * 1024 + lane * 16) = vv; }
        __syncthreads();
        f32x16 p0, p1;
#pragma unroll
        for (int r = 0; r < 16; ++r) { p0[r] = 0.f; p1[r] = 0.f; }
#pragma unroll
        for (int d0 = 0; d0 < 4; ++d0) {
            const bf16x8 b0 = *(const ATT_LAS bf16x8*)(kp + d0 * 2048), b1 = *(const ATT_LAS bf16x8*)(kp + d0 * 2048 + 512);
            p0 = __builtin_amdgcn_mfma_f32_32x32x16_bf16(b0, qr[d0], p0, 0, 0, 0);
            p1 = __builtin_amdgcn_mfma_f32_32x32x16_bf16(b1, qr[d0], p1, 0, 0, 0);
        }
        if (P.mode == 1 && t >= 4) {
            const int kr = P.rlo + (t - 4); const bool rowok = (kr >= rs) && (kr <= rs + 7);
            int dr = kr - qrg + 7; dr = dr < 0 ? 0 : (dr > 14 ? 14 : dr);
            const ATT_LAS float* brow = biasL + dr * 31;
#pragma unroll
            for (int r = 0; r < 16; ++r) {
                const int k0 = crow(r, hi), k1 = k0 + 32;
                int i0 = k0 - qc + 15; i0 = i0 < 0 ? 0 : (i0 > 30 ? 30 : i0);
                int i1 = k1 - qc + 15; i1 = i1 < 0 ? 0 : (i1 > 30 ? 30 : i1);
                const bool ok0 = rowok && (k0 >= cs) && (k0 <= cs + 15), ok1 = rowok && (k1 >= cs) && (k1 <= cs + 15);
                p0[r] = ok0 ? p0[r] + brow[i0] : -INFINITY;
                p1[r] = ok1 ? p1[r] + brow[i1] : -INFINITY;
            }
        }
        float mx = fmaxf(p0[0], p1[0]);
#pragma unroll
        for (int r = 1; r < 16; ++r) mx = fmaxf(mx, fmaxf(p0[r], p1[r]));
        mx = fmaxf(mx, __shfl_xor(mx, 32));
        const float mn = fmaxf(m, mx); const float alpha = __builtin_amdgcn_exp2f(m - mn); m = mn;
        float s = 0.f;
#pragma unroll
        for (int r = 0; r < 16; ++r) { p0[r] = __builtin_amdgcn_exp2f(p0[r] - mn); p1[r] = __builtin_amdgcn_exp2f(p1[r] - mn); s += p0[r] + p1[r]; }
        l = l * alpha + s;
        if (hi == 0) wsf[r32] = alpha;
#pragma unroll
        for (int r = 0; r < 16; ++r) { const float f = wsf[crow(r, hi)]; o[0][r] *= f; o[1][r] *= f; }
        bf16x8 pa[4];
#pragma unroll
        for (int ks = 0; ks < 4; ++ks) {
            u32x4 w;
            if (ks < 2) { w.x = cvtpk(p0[8 * ks + 0], p0[8 * ks + 1]); w.y = cvtpk(p0[8 * ks + 2], p0[8 * ks + 3]); w.z = cvtpk(p0[8 * ks + 4], p0[8 * ks + 5]); w.w = cvtpk(p0[8 * ks + 6], p0[8 * ks + 7]); }
            else { const int q = ks - 2; w.x = cvtpk(p1[8 * q + 0], p1[8 * q + 1]); w.y = cvtpk(p1[8 * q + 2], p1[8 * q + 3]); w.z = cvtpk(p1[8 * q + 4], p1[8 * q + 5]); w.w = cvtpk(p1[8 * q + 6], p1[8 * q + 7]); }
            pa[ks] = __builtin_bit_cast(bf16x8, w);
        }
#pragma unroll
        for (int d0 = 0; d0 < 2; ++d0)
#pragma unroll
            for (int ks = 0; ks < 4; ++ks) {
                const s16x4 lo = vtr(vp + d0 * 4096 + ks * 1024), h4 = vtr(vp + d0 * 4096 + ks * 1024 + 512);
                const bf16x8 vb = (bf16x8){lo[0], lo[1], lo[2], lo[3], h4[0], h4[1], h4[2], h4[3]};
                o[d0] = __builtin_amdgcn_mfma_f32_32x32x16_bf16(pa[ks], vb, o[d0], 0, 0, 0);
            }
    }
    l += __shfl_xor(l, 32);
    if (hi == 0) wsf[32 + r32] = l;
    ATT_LAS bf16_t* stg = (ATT_LAS bf16_t*)(shm + LDS_OST) + wid * 2048;
#pragma unroll
    for (int r = 0; r < 16; ++r) { const int orow = crow(r, hi); const float rl = 1.0f / wsf[32 + orow];
        const unsigned a = cvtpk(o[0][r] * rl, 0.f), b = cvtpk(o[1][r] * rl, 0.f);
        stg[orow * 64 + r32] = (bf16_t)(a & 0xffffu); stg[orow * 64 + 32 + r32] = (bf16_t)(b & 0xffffu); }
    bf16_t* Ow = O + (size_t)(P.qrow0 + wid * 32) * DM + P.ocol;
#pragma unroll
    for (int i = 0; i < 4; ++i) { const int row = i * 8 + (lane >> 3), ch = lane & 7; const u32x4 v = *(const ATT_LAS u32x4*)(stg + row * 64 + ch * 8); *(u32x4*)(Ow + (size_t)row * DM + ch * 8) = v; }
    __syncthreads();
}
}
#define GAS __attribute__((address_space(1)))
#define LAS __attribute__((address_space(3)))
typedef unsigned short bf16;
typedef unsigned v4u __attribute__((ext_vector_type(4)));
typedef float f32x4 __attribute__((ext_vector_type(4)));
constexpr int NWAVES = 8;
constexpr int LDS_BYTES = 147456;
constexpr size_t MiB = 1u << 20;
constexpr size_t WS_CTL = 0;
constexpr size_t WS_MOD = 1 * MiB;
constexpr size_t WS_ROPE = WS_MOD + 960 * 1024;
constexpr size_t WS_W = 2 * MiB;
constexpr size_t W_IN = 0, W_OUT = (size_t)QKVN * DM * 2, W_GU = W_OUT + (size_t)DM * DM * 2, W_DN = W_GU + (size_t)GUN * DM * 2, W_LAYER = W_DN + (size_t)DM * FF * 2;
static_assert(W_LAYER == 23 * MiB, "weights per layer");
constexpr size_t WS_CTXB = 94 * MiB;
constexpr size_t WS_XN = 102 * MiB;
constexpr size_t WS_QKV = 138 * MiB;
constexpr size_t WS_O = 219 * MiB;
constexpr size_t WS_H = 138 * MiB;
constexpr size_t WS_ADAP = 138 * MiB;
constexpr size_t WS_END = 255 * MiB;
static_assert(WS_W + 4 * W_LAYER <= WS_CTXB && WS_QKV + (size_t)NROWS * QKVN * 2 <= WS_O && WS_O + (size_t)NROWS * DM * 2 <= WS_END && WS_H + (size_t)NROWS * FF * 2 <= WS_END, "ws map");

__device__ __forceinline__ unsigned f2bf(float f) { unsigned u = __builtin_bit_cast(unsigned, f); return (u + 0x7fffu + ((u >> 16) & 1u)) >> 16; }
__device__ __forceinline__ unsigned pk2(float lo, float hi) { return f2bf(lo) | (f2bf(hi) << 16); }
__device__ __forceinline__ float wave_sum(float v) {
#pragma unroll
    for (int o = 1; o < 64; o <<= 1) v += __shfl_xor(v, o);
    return v;
}
__device__ __forceinline__ void transpose_item(const float* W, int K, int N, bf16* WT, int k0, int n0, int drow0, LAS float* scr, int lane) {
#pragma unroll 8
    for (int i = 0; i < 32; ++i) { const int kk = 2 * i + (lane >> 5); scr[kk * 33 + (lane & 31)] = W[(size_t)(k0 + kk) * N + n0 + (lane & 31)]; }
    asm volatile("s_waitcnt lgkmcnt(0)" ::: "memory");
    const int c = lane & 7;
#pragma unroll
    for (int j = 0; j < 4; ++j) { const int n = (lane >> 3) + 8 * j; const LAS float* s = scr + (8 * c) * 33 + n;
        v4u o; o.x = pk2(s[0 * 33], s[1 * 33]); o.y = pk2(s[2 * 33], s[3 * 33]); o.z = pk2(s[4 * 33], s[5 * 33]); o.w = pk2(s[6 * 33], s[7 * 33]);
        *(v4u*)(WT + (size_t)(drow0 + n) * K + k0 + 8 * c) = o; }
    asm volatile("s_waitcnt lgkmcnt(0)" ::: "memory");
}

typedef GAS unsigned gu32;
#define RLX_AGENT __ATOMIC_RELAXED, __HIP_MEMORY_SCOPE_AGENT
constexpr int RING_BYTES = 131072, LDSCTL_OFF = RING_BYTES, MISC_OFF = LDSCTL_OFF + 320;
constexpr int CW_BAR = 4096;
constexpr size_t CTL_ZERO_BYTES = 64 * 1024;
#define XB_TMO      128
#define XB_XCNT(j)  (256  + 64 * (j))
#define XB_XSUB(j)  (1280 + 64 * (j))
#define XB_XGEN(j)  (2304 + 64 * (j))
#define XB_TOP      3328
#define XB_TOPGEN   3392
#define XCD_BAR_WORDS 3456
#define XB_SPIN_CAP (1u << 18)

__device__ __forceinline__ unsigned xb_ld(unsigned* p)              { return __hip_atomic_load(p, __ATOMIC_RELAXED, __HIP_MEMORY_SCOPE_AGENT); }
__device__ __forceinline__ unsigned xb_add(unsigned* p, unsigned v) { return __hip_atomic_fetch_add(p, v, __ATOMIC_RELAXED, __HIP_MEMORY_SCOPE_AGENT); }
__device__ __forceinline__ unsigned xb_xcc_id() { return (unsigned)__builtin_amdgcn_s_getreg((3 << 11) | 20) & 0xFu; }
#define XB_SPIN(cond, bar) do { unsigned _sp = 0; while (cond) { __builtin_amdgcn_s_sleep(1); \
    if ((++_sp & 255u) == 0u) { if (xb_ld(&(bar)[XB_TMO])) break; if (_sp > XB_SPIN_CAP) { atomicAdd(&(bar)[XB_TMO], 1u); break; } } } } while (0)

struct XcdBarrier {
    unsigned* bar; unsigned x;
    volatile LAS unsigned* st;
};

__device__ __forceinline__ XcdBarrier xcd_barrier_post(unsigned* bar, volatile LAS unsigned* st) {
    XcdBarrier b; b.bar = bar; b.x = xb_xcc_id(); b.st = st;
    if (threadIdx.x == 0) (void)xb_add(&bar[XB_XCNT(b.x)], 1u);
    return b;
}
__device__ __forceinline__ void xcd_barrier_complete(unsigned* bar, unsigned x, unsigned& nloc, unsigned& nx) {
    const unsigned G = gridDim.x * gridDim.y * gridDim.z;
    unsigned sum, cnt, mine, sp = 0u;
    for (;;) {
        sum = 0u; cnt = 0u; mine = 0u;
#pragma unroll
        for (unsigned j = 0; j < 16; ++j) { const unsigned c = xb_ld(&bar[XB_XCNT(j)]); sum += c; cnt += (c > 0u) ? 1u : 0u; mine = (j == x) ? c : mine; }
        if (sum == G) break;
        __builtin_amdgcn_s_sleep(1);
        if ((++sp & 255u) == 0u) { if (xb_ld(&bar[XB_TMO])) break; if (sp > XB_SPIN_CAP) { atomicAdd(&bar[XB_TMO], 1u); break; } }
    }
    nloc = mine > 0u ? mine : 1u; nx = cnt > 0u ? cnt : 1u;
}

__device__ __forceinline__ void xcd_barrier(const XcdBarrier& b) {
    asm volatile("s_waitcnt vmcnt(0)" ::: "memory");
    __syncthreads();
    if (threadIdx.x == 0) {
        unsigned* bar = b.bar;
        __builtin_amdgcn_s_waitcnt(0);
        unsigned nloc = b.st[0], nx = b.st[1];
        if (nloc == 0u) { xcd_barrier_complete(bar, b.x, nloc, nx); b.st[0] = nloc; b.st[1] = nx; }
        const unsigned old = xb_add(&bar[XB_XSUB(b.x)], 1u);
        const unsigned gen = old / nloc;
        if (old + 1u == (gen + 1u) * nloc) {
            __builtin_amdgcn_fence(__ATOMIC_RELEASE, "agent");
            asm volatile("s_waitcnt vmcnt(0)" ::: "memory");
            const unsigned og = xb_add(&bar[XB_TOP], 1u);
            const unsigned tg = og / nx;
            if (og + 1u == (tg + 1u) * nx) xb_add(&bar[XB_TOPGEN], 1u);
            else XB_SPIN(xb_ld(&bar[XB_TOPGEN]) == tg, bar);
            __builtin_amdgcn_fence(__ATOMIC_ACQUIRE, "agent");
            xb_add(&bar[XB_XGEN(b.x)], 1u);
            asm volatile("s_waitcnt vmcnt(0)" ::: "memory");
        } else {
            XB_SPIN(xb_ld(&bar[XB_XGEN(b.x)]) == gen, bar);
            __builtin_amdgcn_fence(__ATOMIC_ACQUIRE, "agent");
            asm volatile("s_waitcnt vmcnt(0)" ::: "memory");
        }
    }
    __syncthreads();
}

struct Args { const float* in[18]; float* out; unsigned char* ws; int ph_lo, ph_hi; };
enum { I_X = 0, I_C, I_CTX, I_CCTX, I_WADA, I_BADA, I_ANORM, I_WIN, I_QNA, I_KNA, I_QNB, I_KNB, I_RPB, I_WOUT, I_FNORM, I_WG, I_WU, I_WD };

__device__ __forceinline__ void norm_rows(const float* xlat, const float* xctx, const float* g, const float* modl, int shift_chunk, bf16* XN, int gw, int NGW, int lane) {
    asm volatile("" : "+v"(lane));
    f32x4 gv[4];
#pragma unroll
    for (int j = 0; j < 4; ++j) gv[j] = *((const f32x4*)g + lane + 64 * j);
    for (int row = gw; row < NROWS; row += NGW) {
        const bool lat = row < NLAT; const float* xr = lat ? xlat + (size_t)row * DM : xctx + (size_t)(row - NLAT) * DM;
        const int bidx = lat ? (row >> 11) : 8;
        const float* sh = modl + bidx * 6144 + shift_chunk * 1024; const float* sc = sh + 1024;
        f32x4 v[4]; float ss = 0.f;
#pragma unroll
        for (int j = 0; j < 4; ++j) { v[j] = *((const f32x4*)xr + lane + 64 * j); ss += (v[j][0] * v[j][0] + v[j][1] * v[j][1]) + (v[j][2] * v[j][2] + v[j][3] * v[j][3]); }
        const float rstd = 1.0f / sqrtf(wave_sum(ss) * (1.0f / DM) + EPS);
        unsigned long long* o8 = (unsigned long long*)(XN + (size_t)row * DM) + lane;
#pragma unroll
        for (int j = 0; j < 4; ++j) { const f32x4 s4 = *((const f32x4*)sh + lane + 64 * j), c4 = *((const f32x4*)sc + lane + 64 * j);
            const f32x4 y = (v[j] * rstd * gv[j]) * (c4 + 1.0f) + s4;
            o8[64 * j] = (unsigned long long)pk2(y[0], y[1]) | ((unsigned long long)pk2(y[2], y[3]) << 32); }
    }
}

__global__ void __launch_bounds__(NWAVES * 64, 2) fwd(Args args) {
    extern __shared__ __attribute__((aligned(16))) unsigned char lds_raw[];
    LAS unsigned char* lds = (LAS unsigned char*)lds_raw;
    cg::grid_group grid = cg::this_grid();
    const int tid = threadIdx.x, lane = tid & 63, wave = __builtin_amdgcn_readfirstlane(tid >> 6);
    const int G = gridDim.x, bx = blockIdx.x;
    const int gw = bx * NWAVES + wave, NGW = G * NWAVES;
    unsigned char* ws = args.ws;
    float* MOD = (float*)(ws + WS_MOD); float* ROPEC = (float*)(ws + WS_ROPE); float* ROPES = ROPEC + 1024;
    float* CTXB = (float*)(ws + WS_CTXB); bf16* XN = (bf16*)(ws + WS_XN); bf16* QKV = (bf16*)(ws + WS_QKV); bf16* OB = (bf16*)(ws + WS_O); bf16* HB = (bf16*)(ws + WS_H);
    float* ADAP = (float*)(ws + WS_ADAP);
    float* XOUT = args.out;
    for (int u = tid; u < (LDS_BYTES - LDSCTL_OFF) / 4; u += NWAVES * 64) ((LAS unsigned*)(lds + LDSCTL_OFF))[u] = 0u;
    __syncthreads();
    (void)xcd_barrier_post((unsigned*)(ws + WS_CTL) + CW_BAR, (volatile LAS unsigned*)(lds + MISC_OFF) + 8);
#define SEAM() do { unsigned char* w_ = args.ws; asm volatile("" : "+s"(w_)); XcdBarrier b_; b_.bar = (unsigned*)(w_ + WS_CTL) + CW_BAR; b_.x = xb_xcc_id(); b_.st = (volatile LAS unsigned*)(lds + MISC_OFF) + 8; xcd_barrier(b_); } while (0)

    {
        LAS float* sl = (LAS float*)lds;
        for (int i = tid; i < 9 * 1024; i += NWAVES * 64) { const float c = (i < 8192) ? args.in[I_C][i] : args.in[I_CCTX][i - 8192]; sl[i] = c * __builtin_amdgcn_rcpf(1.0f + __expf(-c)); }
        __syncthreads();
        for (int it = gw; it < 4 * 96 * 8; it += NGW) {
            const int kc = it & 7, cc = (it >> 3) % 96, l = it / 768;
            const float* W = args.in[I_WADA] + (size_t)l * DM * 6144 + (size_t)(kc * 128) * 6144 + cc * 64 + lane;
            float a[9];
#pragma unroll
            for (int i = 0; i < 9; ++i) a[i] = 0.f;
#pragma unroll 2
            for (int k4 = 0; k4 < 32; ++k4) {
                float w[4];
#pragma unroll
                for (int j = 0; j < 4; ++j) w[j] = W[(size_t)(k4 * 4 + j) * 6144];
#pragma unroll
                for (int i = 0; i < 9; ++i) { const f32x4 s4 = *(const LAS f32x4*)(sl + i * 1024 + kc * 128 + k4 * 4); a[i] += (s4[0] * w[0] + s4[1] * w[1]) + (s4[2] * w[2] + s4[3] * w[3]); }
            }
#pragma unroll
            for (int i = 0; i < 9; ++i) ADAP[((size_t)(kc * 4 + l) * 9 + i) * 6144 + cc * 64 + lane] = a[i];
        }
        LAS float* scr = (LAS float*)(lds + 36864 + wave * 8448);
        constexpr int IT_IN = 16 * 72, IT_OUT = 16 * 32, IT_G = 16 * 88, IT_D = 44 * 32, IT_L = IT_IN + IT_OUT + 2 * IT_G + IT_D;
        for (int it = gw; it < 4 * IT_L; it += NGW) {
            const int l = it / IT_L; int r = it % IT_L;
            bf16* WL = (bf16*)(ws + WS_W + (size_t)l * W_LAYER);
            if (r < IT_IN) { const int kb = r / 72, nb = r % 72, n0 = 32 * nb, cl = n0 & 255;
                const int drow0 = (n0 & ~255) + 128 * ((cl & 63) >> 5) + 32 * (cl >> 6);
                transpose_item(args.in[I_WIN] + (size_t)l * DM * QKVN, DM, QKVN, (bf16*)((unsigned char*)WL + W_IN), 64 * kb, n0, drow0, scr, lane); continue; }
            r -= IT_IN;
            if (r < IT_OUT) { const int kb = r / 32, nb = r % 32;
                transpose_item(args.in[I_WOUT] + (size_t)l * DM * DM, DM, DM, (bf16*)((unsigned char*)WL + W_OUT), 64 * kb, 32 * nb, 32 * nb, scr, lane); continue; }
            r -= IT_OUT;
            if (r < 2 * IT_G) { const int up = r >= IT_G; if (up) r -= IT_G; const int kb = r / 88, nb = r % 88, n0 = 32 * nb;
                const int drow0 = 256 * (n0 >> 7) + 128 * up + (n0 & 127);
                transpose_item(args.in[up ? I_WU : I_WG] + (size_t)l * DM * FF, DM, FF, (bf16*)((unsigned char*)WL + W_GU), 64 * kb, n0, drow0, scr, lane); continue; }
            r -= 2 * IT_G;
            { const int kb = r / 32, nb = r % 32;
                transpose_item(args.in[I_WD] + (size_t)l * FF * DM, FF, DM, (bf16*)((unsigned char*)WL + W_DN), 64 * kb, 32 * nb, 32 * nb, scr, lane); }
        }
        for (int i = gw * 64 + lane; i < NCTX * DM / 4; i += NGW * 64) ((f32x4*)CTXB)[i] = ((const f32x4*)args.in[I_CTX])[i];
        if (bx == 0 && tid < 16) {
            const double cb[16] = {0.5403023058681398, 0.8460091102817079, 0.9504152802551828, 0.9842302344700946, 0.9950041652780258, 0.9984192777926645, 0.9995000416652778, 0.9998418902836144,
                                   0.9999500004166653, 0.9999841886533658, 0.9999950000041666, 0.9999984188615866, 0.9999995000000417, 0.9999998418861211, 0.9999999500000004, 0.9999999841886117};
            const double sb[16] = {0.8414709848078965, 0.5331684399140229, 0.31098359290718575, 0.17689218624615005, 0.09983341664682815, 0.05620449921469249, 0.03161750640243371, 0.01778185687966613,
                                   0.009999833334166664, 0.005623383613960186, 0.0031622723897082477, 0.0017782784728035289, 0.0009999998333333417, 0.0005623412955523594, 0.0003162277607463752, 0.00017782794006665674};
            double c1 = 1.0, s1 = 0.0, cf = 1.0, sf = 0.0;
#pragma unroll
            for (int i = 0; i < 16; ++i) if (i == tid) { cf = cb[i]; sf = sb[i]; }
            for (int p = 0; p < 64; ++p) { ROPEC[p * 16 + tid] = (float)c1; ROPES[p * 16 + tid] = (float)s1; const double cn = c1 * cf - s1 * sf, sn = s1 * cf + c1 * sf; c1 = cn; s1 = sn; }
        }
    }
    grid.sync();
    for (int e = gw * 64 + lane; e < 4 * 9 * 6144; e += NGW * 64) {
        const int n = e % 6144, li = e / 6144, l = li / 9;
        float s = args.in[I_BADA][l * 6144 + n];
#pragma unroll
        for (int kc = 0; kc < 8; ++kc) s += ADAP[(size_t)kc * 4 * 9 * 6144 + e];
        MOD[e] = s;
    }
    SEAM();

    for (int l = 0; l < DEPTH; ++l) {
        const float* modl = MOD + (size_t)l * 9 * 6144;
        const float* xsrc = (l == 0) ? args.in[I_X] : XOUT;
        const bf16* WL = (const bf16*)(ws + WS_W + (size_t)l * W_LAYER);
        norm_rows(xsrc, CTXB, args.in[I_ANORM] + l * DM, modl, 0, XN, gw, NGW, lane);
        SEAM();
        { pg8::Gemm g{XN, (const bf16*)((const unsigned char*)WL + W_IN), NROWS, QKVN, DM}; pg8::StaticOrder S; S.init(NROWS, QKVN, G, bx);
          pg8::EpiQKV E{QKV, args.in[I_QNA] + l * HD, args.in[I_KNA] + l * HD, args.in[I_QNB] + l * HD, args.in[I_KNB] + l * HD, ROPEC, ROPES};
          pg8::gemm_phase<pg8::EpiQKV, pg8::StaticOrder, true, true>(lds, g, S, E); }
        SEAM();
        { const int nunits = 1152;
          for (int u = bx; u < nunits; u += G) { att::UnitP P; att::make_unit(u, l, args.in[I_RPB], P); att::attn_unit(P, QKV, OB, lds); } }
        SEAM();
        { pg8::Gemm g{OB, (const bf16*)((const unsigned char*)WL + W_OUT), NROWS, DM, DM}; pg8::StaticOrder S; S.init(NROWS, DM, G, bx);
          pg8::EpiRes E{xsrc, CTXB, XOUT, CTXB, modl + 2 * 1024};
          pg8::gemm_phase<pg8::EpiRes, pg8::StaticOrder, true, true>(lds, g, S, E); }
        SEAM();
        norm_rows(XOUT, CTXB, args.in[I_FNORM] + l * DM, modl, 3, XN, gw, NGW, lane);
        SEAM();
        { pg8::Gemm g{XN, (const bf16*)((const unsigned char*)WL + W_GU), NROWS, GUN, DM}; pg8::StaticOrder S; S.init(NROWS, GUN, G, bx);
          pg8::EpiGU E{HB};
          pg8::gemm_phase<pg8::EpiGU, pg8::StaticOrder, true, true>(lds, g, S, E); }
        SEAM();
        { pg8::Gemm g{HB, (const bf16*)((const unsigned char*)WL + W_DN), NROWS, DM, FF}; pg8::StaticOrder S; S.init(NROWS, DM, G, bx);
          pg8::EpiRes E{XOUT, CTXB, XOUT, CTXB, modl + 5 * 1024};
          pg8::gemm_phase<pg8::EpiRes, pg8::StaticOrder, true, true>(lds, g, S, E); }
        SEAM();
    }
}

extern "C" void kernel_launch(void* const* d_in, const int* in_sizes, int n_in, void* d_out, int out_size, void* d_ws, size_t ws_size, hipStream_t stream) {
    static int grid = 0;
    if (grid == 0) {
        if (n_in != 18 || ws_size < WS_END) { fprintf(stderr, "kernel_launch: unexpected n_in %d / ws_size %zu\n", n_in, ws_size); grid = -1; return; }
        int dev = 0, cus = 0, per_cu = 0;
        hipGetDevice(&dev); hipDeviceGetAttribute(&cus, hipDeviceAttributeMultiprocessorCount, dev);
        hipFuncSetAttribute((const void*)fwd, hipFuncAttributeMaxDynamicSharedMemorySize, LDS_BYTES);
        hipOccupancyMaxActiveBlocksPerMultiprocessor(&per_cu, (const void*)fwd, NWAVES * 64, LDS_BYTES);
        if (per_cu < 1) { fprintf(stderr, "kernel_launch: occupancy query says %d blocks per CU\n", per_cu); per_cu = 1; }
        (void)hipGetLastError();
        grid = cus;
    }
    if (grid < 0) return;
    if (hipMemsetAsync((char*)d_ws + WS_CTL, 0, CTL_ZERO_BYTES, stream) != hipSuccess) { fprintf(stderr, "kernel_launch: memset failed\n"); return; }
    Args a{};
    for (int i = 0; i < 18; ++i) a.in[i] = (const float*)d_in[i];
    a.out = (float*)d_out; a.ws = (unsigned char*)d_ws; a.ph_lo = 0; a.ph_hi = 0;
    void* kargs[] = {&a};
    hipError_t e = hipLaunchCooperativeKernel((const void*)fwd, dim3(grid), dim3(NWAVES * 64), kargs, LDS_BYTES, stream);
    if (e != hipSuccess) fprintf(stderr, "cooperative launch failed: %s (grid %d)\n", hipGetErrorString(e), grid);
}
```

```cpp
#include <hip/hip_runtime.h>
#include <hip/hip_cooperative_groups.h>
#include <hip/hip_bf16.h>
#include <cstdio>
#include <cstdint>
namespace cg = cooperative_groups;

constexpr int NB = 8, SEQ = 2048, DM = 1024, DEPTH = 4, CTXL = 256, HD = 64;
constexpr int NLAT = NB * SEQ;
constexpr int NCTX = NB * CTXL;
constexpr int NROWS = NLAT + NCTX;
constexpr int QKVN = 2304, FF = 2816, GUN = 2 * FF;
constexpr float EPS = 1e-6f;
constexpr float LOG2E = 1.4426950408889634f;
constexpr float C2 = 0.125f * LOG2E;
namespace pg8 {
#define PG8_LAS __attribute__((address_space(3)))
typedef unsigned short bf16_t;
typedef short bf16x8 __attribute__((ext_vector_type(8)));
typedef float f32x4 __attribute__((ext_vector_type(4)));
typedef unsigned u32x4 __attribute__((ext_vector_type(4)));
constexpr int BM = 256, BK = 64, HALF = 128, HTB = HALF * BK * 2  , STAGE_BYTES = 8 * HTB, NXCD = 8, WGM = 8;

__host__ __device__ __forceinline__ int lds_byte(int r, int c) { const int st = (r >> 4) * 2 + (c >> 5), rr = r & 15, cc = c & 31, ob = rr * 64 + cc * 2; return st * 1024 + (ob ^ (((ob >> 9) & 1) << 5)); }
__host__ __device__ __forceinline__ void stage_rc(int b, int& R, int& C) { const int st = b / 1024, sb = b % 1024, swz = sb ^ (((sb >> 9) & 1) << 5); R = (st >> 1) * 16 + swz / 64; C = (st & 1) * 32 + (swz % 64) / 2; }
__host__ __device__ __forceinline__ int perm32(int rho) { const int n = rho >> 4, i = rho & 15; return 8 * (i >> 2) + 4 * n + (i & 3); }

struct Unit { int pm, pn; };
struct Gemm { const bf16_t* A; const bf16_t* Bt; int M, N, K; };

struct StaticOrder {
    int nM, nN, nwg, G, c;
    __host__ __device__ void init(int M, int N, int G_, int c_) { nM = M / BM; nN = N / BM; nwg = nM * nN; G = G_; c = c_; }
    __host__ __device__ bool next(int i, Unit& u) const {
        const long L = (long)i * G + c; if (L >= nwg) return false;
        int wgid = (int)L; { const int q = nwg / NXCD, r = nwg % NXCD, xcd = wgid % NXCD, off = wgid / NXCD; wgid = (xcd < r ? xcd * (q + 1) : r * (q + 1) + (xcd - r) * q) + off; }
        const int nig = WGM * nN, gid = wgid / nig, fm = gid * WGM, gsz = (nM - fm) < WGM ? (nM - fm) : WGM;
        u.pm = fm + ((wgid % nig) % gsz); u.pn = (wgid % nig) / gsz; return true;
    }
    __device__ __forceinline__ void a_ready(const Unit&) const {}
    __device__ __forceinline__ void done(const Unit&) const {}
};

__device__ __forceinline__ unsigned cvt_pk_bf16(float lo, float hi) { unsigned r; asm volatile("v_cvt_pk_bf16_f32 %0, %1, %2" : "=v"(r) : "v"(lo), "v"(hi)); return r; }
typedef unsigned u32x2 __attribute__((ext_vector_type(2)));

struct EpiQKV {
    static constexpr bool PERM = false, AFTER_DRAIN = false;
    bf16_t* QKV; const float* qn_a; const float* kn_a; const float* qn_b; const float* kn_b; const float* ropeC; const float* ropeS;
    __device__ __forceinline__ void operator()(const f32x4 (&acc)[2][2][4][2], const Unit& u, int wr, int wc, int fr, int fq) const {
        const int pn = u.pn;
        int kind; bool rope; const float* gain;
        if (pn < 2) { kind = 0; gain = qn_a; rope = false; }
        else if (pn < 4) { kind = 1; gain = kn_a; rope = false; }
        else if (pn < 6) { kind = 2; gain = qn_a; rope = false; }
        else if (pn < 8) { kind = 0; gain = qn_b; rope = true; }
        else if (wc < 2) { kind = 1; gain = kn_b; rope = true; }
        else { kind = 2; gain = kn_b; rope = false; }
        rope = rope && (u.pm < 64);
        f32x4 gv[2][2];
#pragma unroll
        for (int bj = 0; bj < 2; ++bj)
#pragma unroll
            for (int n = 0; n < 2; ++n) gv[bj][n] = *(const __attribute__((address_space(1))) f32x4*)(gain + 32 * bj + 16 * n + 4 * fq);
        const float qs = (kind == 0) ? C2 : 1.f;
#pragma unroll
        for (int ai = 0; ai < 2; ++ai)
#pragma unroll
            for (int m = 0; m < 4; ++m) {
                const int row = u.pm * BM + ai * HALF + wr * 64 + m * 16 + fr;
                f32x4 v[2][2];
#pragma unroll
                for (int bj = 0; bj < 2; ++bj)
#pragma unroll
                    for (int n = 0; n < 2; ++n) v[bj][n] = acc[ai][bj][m][n];
                if (kind != 2) {
                    float ss = 0.f;
#pragma unroll
                    for (int bj = 0; bj < 2; ++bj)
#pragma unroll
                        for (int n = 0; n < 2; ++n) { const f32x4 x = v[bj][n]; ss += (x[0] * x[0] + x[1] * x[1]) + (x[2] * x[2] + x[3] * x[3]); }
                    ss += __shfl_xor(ss, 16); ss += __shfl_xor(ss, 32);
                    const float rstd = 1.0f / sqrtf(ss * (1.0f / 64.0f) + EPS);
#pragma unroll
                    for (int bj = 0; bj < 2; ++bj)
#pragma unroll
                        for (int n = 0; n < 2; ++n) v[bj][n] = v[bj][n] * rstd * gv[bj][n];
                    if (rope) {
                        const int t = row & (SEQ - 1), gr = t >> 6, gc = t & 63;
                        const f32x4 cr = *(const __attribute__((address_space(1))) f32x4*)(ropeC + gr * 16 + 4 * fq), sr = *(const __attribute__((address_space(1))) f32x4*)(ropeS + gr * 16 + 4 * fq);
                        const f32x4 cc = *(const __attribute__((address_space(1))) f32x4*)(ropeC + gc * 16 + 4 * fq), sc = *(const __attribute__((address_space(1))) f32x4*)(ropeS + gc * 16 + 4 * fq);
                        const f32x4 a1 = v[0][0], a2 = v[0][1]; v[0][0] = a1 * cr - a2 * sr; v[0][1] = a2 * cr + a1 * sr;
                        const f32x4 b1 = v[1][0], b2 = v[1][1]; v[1][0] = b1 * cc - b2 * sc; v[1][1] = b2 * cc + b1 * sc;
                    }
#pragma unroll
                    for (int bj = 0; bj < 2; ++bj)
#pragma unroll
                        for (int n = 0; n < 2; ++n) v[bj][n] = v[bj][n] * qs;
                }
                bf16_t* rowp = QKV + (size_t)row * QKVN + pn * BM + wc * 64 + 4 * fq;
#pragma unroll
                for (int bj = 0; bj < 2; ++bj)
#pragma unroll
                    for (int n = 0; n < 2; ++n) { u32x2 w; w.x = cvt_pk_bf16(v[bj][n][0], v[bj][n][1]); w.y = cvt_pk_bf16(v[bj][n][2], v[bj][n][3]); *(__attribute__((address_space(1))) u32x2*)(rowp + 32 * bj + 16 * n) = w; }
            }
    }
};
struct EpiGU {
    static constexpr bool PERM = true, AFTER_DRAIN = false;
    bf16_t* H;
    __device__ __forceinline__ void operator()(const f32x4 (&acc)[2][2][4][2], const Unit& u, int wr, int wc, int fr, int fq) const {
#pragma unroll
        for (int ai = 0; ai < 2; ++ai)
#pragma unroll
            for (int m = 0; m < 4; ++m) {
                const int row = u.pm * BM + ai * HALF + wr * 64 + m * 16 + fr;
                float h[8];
#pragma unroll
                for (int n = 0; n < 2; ++n)
#pragma unroll
                    for (int e = 0; e < 4; ++e) { const float g = acc[ai][0][m][n][e], up = acc[ai][1][m][n][e]; h[4 * n + e] = g * __builtin_amdgcn_rcpf(1.0f + __expf(-g)) * up; }
                u32x4 w; w.x = cvt_pk_bf16(h[0], h[1]); w.y = cvt_pk_bf16(h[2], h[3]); w.z = cvt_pk_bf16(h[4], h[5]); w.w = cvt_pk_bf16(h[6], h[7]);
                *(__attribute__((address_space(1))) u32x4*)(H + (size_t)row * FF + u.pn * 128 + wc * 32 + 8 * fq) = w;
            }
    }
};
struct EpiRes {
    static constexpr bool PERM = false, AFTER_DRAIN = false;
    const float* src_lat; const float* src_ctx; float* dst_lat; float* dst_ctx; const float* gate;
    __device__ __forceinline__ void operator()(const f32x4 (&acc)[2][2][4][2], const Unit& u, int wr, int wc, int fr, int fq) const {
        const bool lat = u.pm < 64; const int bidx = lat ? (u.pm >> 3) : 8;
        const float* src = lat ? src_lat + (size_t)u.pm * BM * DM : src_ctx + (size_t)(u.pm - 64) * BM * DM;
        float* dst = lat ? dst_lat + (size_t)u.pm * BM * DM : dst_ctx + (size_t)(u.pm - 64) * BM * DM;
        const int col0 = u.pn * BM + wc * 32 + 4 * fq;
        f32x4 gv[2][2];
#pragma unroll
        for (int bj = 0; bj < 2; ++bj)
#pragma unroll
            for (int n = 0; n < 2; ++n) gv[bj][n] = *(const __attribute__((address_space(1))) f32x4*)(gate + bidx * 6144 + col0 + bj * HALF + n * 16);
#pragma unroll
        for (int ai = 0; ai < 2; ++ai)
#pragma unroll
            for (int m = 0; m < 4; ++m) {
                const size_t off = (size_t)(ai * HALF + wr * 64 + m * 16 + fr) * DM + col0;
#pragma unroll
                for (int bj = 0; bj < 2; ++bj)
#pragma unroll
                    for (int n = 0; n < 2; ++n) { const f32x4 xs = *(const __attribute__((address_space(1))) f32x4*)(src + off + bj * HALF + n * 16); *(__attribute__((address_space(1))) f32x4*)(dst + off + bj * HALF + n * 16) = xs + gv[bj][n] * acc[ai][bj][m][n]; }
            }
    }
};
template <class Epi, class Sched, bool ALIGN_EPI = false, bool SP2 = false>
__device__ __forceinline__ void gemm_phase(PG8_LAS unsigned char* lds, const Gemm g, const Sched& S, const Epi& E) {
    int tid_ = threadIdx.x; asm volatile("" : "+v"(tid_));
    const int tid = tid_, wid = __builtin_amdgcn_readfirstlane(tid >> 6), lane = tid & 63, wr = wid >> 2, wc = wid & 3, fr = lane & 15, fq = lane >> 4;
    const int K = g.K, nt = K / BK;
    unsigned voffA[2], voffB[2];
#pragma unroll
    for (int i = 0; i < 2; ++i) { int R, C; stage_rc(tid * 16 + i * 8192, R, C); const int Rb = Epi::PERM ? ((R & ~31) + perm32(R & 31)) : R;
        voffA[i] = (unsigned)(R * K + C) * 2u; voffB[i] = (unsigned)(Rb * K + C) * 2u; }
    const size_t kstep = (size_t)(BK * 2);
    const size_t hstep = (size_t)HALF * K * 2;
    const size_t tstep = 2 * hstep;
    const unsigned ldsw = (unsigned)wid * 1024u;
    const int aoff = lds_byte(wr * 64 + fr, fq * 8), boff = lds_byte(wc * 32 + fr, fq * 8);
#define PG8_SA(b, h) (((b) * 2 + (h)) * HTB)
#define PG8_SB(b, h) ((4 + (b) * 2 + (h)) * HTB)
#define PG8_STAGE(bufoff, gbase, voff) do { _Pragma("unroll") for (int _i = 0; _i < 2; ++_i) \
        __builtin_amdgcn_global_load_lds((const unsigned*)((const char*)(gbase) + (voff)[_i]), (PG8_LAS unsigned*)(lds + (bufoff) + ldsw + _i * 8192), 16, 0, 0); } while (0)
#define PG8_LDA(dst, b, h) do { _Pragma("unroll") for (int m = 0; m < 4; ++m) _Pragma("unroll") for (int k = 0; k < 2; ++k) dst[m][k] = *(const PG8_LAS bf16x8*)(lds + PG8_SA(b, h) + aoff + m * 2048 + k * 1024); } while (0)
#define PG8_LDB(dst, b, h) do { _Pragma("unroll") for (int n = 0; n < 2; ++n) _Pragma("unroll") for (int k = 0; k < 2; ++k) dst[n][k] = *(const PG8_LAS bf16x8*)(lds + PG8_SB(b, h) + boff + n * 2048 + k * 1024); } while (0)
#define PG8_MMA(ai, bj, At, Bt) do { __builtin_amdgcn_s_setprio(1); _Pragma("unroll") for (int m = 0; m < 4; ++m) _Pragma("unroll") for (int n = 0; n < 2; ++n) _Pragma("unroll") for (int k = 0; k < 2; ++k) \
        acc[ai][bj][m][n] = __builtin_amdgcn_mfma_f32_16x16x32_bf16(Bt[n][k], At[m][k], acc[ai][bj][m][n], 0, 0, 0); __builtin_amdgcn_s_setprio(0); } while (0)
#define PG8_WAIT_V(n) asm volatile("s_waitcnt vmcnt(" #n ")" ::: "memory")
#define PG8_WAIT_L(n) asm volatile("s_waitcnt lgkmcnt(" #n ")" ::: "memory")
#define PG8_BAR __builtin_amdgcn_s_barrier()
#define PG8_SCHED __builtin_amdgcn_sched_barrier(0)
    Unit cur, nxt; int ui = 0;
    if (!S.next(0, cur)) return;
    f32x4 acc[2][2][4][2];
#pragma unroll
    for (int a = 0; a < 2; ++a)
#pragma unroll
        for (int b = 0; b < 2; ++b)
#pragma unroll
            for (int m = 0; m < 4; ++m)
#pragma unroll
                for (int n = 0; n < 2; ++n) acc[a][b][m][n] = (f32x4){0.f, 0.f, 0.f, 0.f};
    bf16x8 At[4][2], B0[2][2], B1[2][2];
    const char* cA = (const char*)g.A + (size_t)cur.pm * tstep; const char* cB = (const char*)g.Bt + (size_t)cur.pn * tstep;
    S.a_ready(cur);
    if constexpr (SP2) {
        PG8_STAGE(PG8_SB(0, 0), cB, voffB); PG8_STAGE(PG8_SB(0, 1), cB + hstep, voffB); PG8_STAGE(PG8_SA(0, 0), cA, voffA); PG8_STAGE(PG8_SA(0, 1), cA + hstep, voffA);
        if (wr == 1) PG8_BAR;
        PG8_WAIT_V(2); PG8_BAR;
        PG8_STAGE(PG8_SB(1, 0), cB + kstep, voffB); PG8_STAGE(PG8_SA(1, 0), cA + kstep, voffA); PG8_STAGE(PG8_SB(1, 1), cB + hstep + kstep, voffB);
        PG8_WAIT_V(6); PG8_BAR;
    } else {
        PG8_STAGE(PG8_SB(0, 0), cB, voffB); PG8_STAGE(PG8_SA(0, 0), cA, voffA); PG8_STAGE(PG8_SB(0, 1), cB + hstep, voffB); PG8_STAGE(PG8_SA(0, 1), cA + hstep, voffA);
        if (wr == 1) PG8_BAR;
        PG8_WAIT_V(4); PG8_BAR;
        PG8_STAGE(PG8_SB(1, 0), cB + kstep, voffB); PG8_STAGE(PG8_SA(1, 0), cA + kstep, voffA); PG8_STAGE(PG8_SB(1, 1), cB + hstep + kstep, voffB);
        PG8_WAIT_V(6); PG8_BAR;
    }
    for (;;) {
        const bool has_next = S.next(ui + 1, nxt);
        const char* nA = has_next ? (const char*)g.A + (size_t)nxt.pm * tstep : cA; const char* nB = has_next ? (const char*)g.Bt + (size_t)nxt.pn * tstep : cB;
        for (int t = 0; t < nt; t += 2) {
            const bool last = (t == nt - 2);
            const char* a1 = cA + (size_t)(t + 1) * kstep;
            const char* a2 = last ? nA : cA + (size_t)(t + 2) * kstep; const char* b2 = last ? nB : cB + (size_t)(t + 2) * kstep;
            const char* a3 = a2 + kstep; const char* b3 = b2 + kstep;
            if (last && has_next) S.a_ready(nxt);
            if constexpr (SP2) {
            PG8_LDB(B0, 0, 0); PG8_LDB(B1, 0, 1); PG8_SCHED; PG8_LDA(At, 0, 0); PG8_STAGE(PG8_SA(1, 1), a1 + hstep, voffA);
            PG8_WAIT_V(8); PG8_WAIT_L(0); PG8_BAR; PG8_MMA(0, 0, At, B0); PG8_MMA(0, 1, At, B1); PG8_BAR; PG8_SCHED;
            PG8_LDA(At, 0, 1); PG8_STAGE(PG8_SB(0, 0), b2, voffB); PG8_STAGE(PG8_SB(0, 1), b2 + hstep, voffB); PG8_STAGE(PG8_SA(0, 0), a2, voffA);
            PG8_WAIT_V(8); PG8_WAIT_L(0); PG8_BAR; PG8_MMA(1, 0, At, B0); PG8_MMA(1, 1, At, B1); PG8_BAR; PG8_SCHED;
            PG8_LDB(B0, 1, 0); PG8_LDB(B1, 1, 1); PG8_SCHED; PG8_LDA(At, 1, 0); PG8_STAGE(PG8_SA(0, 1), a2 + hstep, voffA);
            PG8_WAIT_V(8); PG8_WAIT_L(0); PG8_BAR; PG8_MMA(0, 0, At, B0); PG8_MMA(0, 1, At, B1); PG8_BAR; PG8_SCHED;
            PG8_LDA(At, 1, 1); PG8_STAGE(PG8_SB(1, 0), b3, voffB); PG8_STAGE(PG8_SB(1, 1), b3 + hstep, voffB); PG8_STAGE(PG8_SA(1, 0), a3, voffA);
            PG8_WAIT_V(8); PG8_WAIT_L(0); PG8_BAR; PG8_MMA(1, 0, At, B0); PG8_MMA(1, 1, At, B1); PG8_BAR; PG8_SCHED;
            } else {
            PG8_LDB(B0, 0, 0); PG8_SCHED; PG8_LDA(At, 0, 0); PG8_STAGE(PG8_SA(1, 1), a1 + hstep, voffA);
            PG8_WAIT_L(8); PG8_BAR; PG8_WAIT_L(0); PG8_MMA(0, 0, At, B0); PG8_BAR; PG8_SCHED;
            PG8_LDB(B1, 0, 1); PG8_STAGE(PG8_SB(0, 0), b2, voffB);
            PG8_BAR; PG8_WAIT_L(0); PG8_MMA(0, 1, At, B1); PG8_BAR;
            PG8_LDA(At, 0, 1); PG8_STAGE(PG8_SA(0, 0), a2, voffA);
            PG8_BAR; PG8_WAIT_L(0); PG8_MMA(1, 0, At, B0); PG8_BAR; PG8_SCHED;
            PG8_STAGE(PG8_SB(0, 1), b2 + hstep, voffB);
            PG8_WAIT_V(6); PG8_BAR; PG8_MMA(1, 1, At, B1); PG8_BAR;
            PG8_LDB(B0, 1, 0); PG8_SCHED; PG8_LDA(At, 1, 0); PG8_STAGE(PG8_SA(0, 1), a2 + hstep, voffA);
            PG8_WAIT_L(8); PG8_BAR; PG8_WAIT_L(0); PG8_MMA(0, 0, At, B0); PG8_BAR; PG8_SCHED;
            PG8_LDB(B1, 1, 1); PG8_STAGE(PG8_SB(1, 0), b3, voffB);
            PG8_BAR; PG8_WAIT_L(0); PG8_MMA(0, 1, At, B1); PG8_BAR;
            PG8_LDA(At, 1, 1); PG8_STAGE(PG8_SA(1, 0), a3, voffA);
            PG8_BAR; PG8_WAIT_L(0); PG8_MMA(1, 0, At, B0); PG8_BAR; PG8_SCHED;
            PG8_STAGE(PG8_SB(1, 1), b3 + hstep, voffB);
            PG8_WAIT_V(6); PG8_BAR; PG8_MMA(1, 1, At, B1); PG8_BAR;
            }
        }
        if constexpr (ALIGN_EPI) { if (wr == 0) PG8_BAR; }
        if constexpr (!Epi::AFTER_DRAIN) { E(acc, cur, wr, wc, fr, fq); S.done(cur); }
        if (!has_next) break;
#pragma unroll
        for (int a = 0; a < 2; ++a)
#pragma unroll
            for (int b = 0; b < 2; ++b)
#pragma unroll
                for (int m = 0; m < 4; ++m)
#pragma unroll
                    for (int n = 0; n < 2; ++n) acc[a][b][m][n] = (f32x4){0.f, 0.f, 0.f, 0.f};
        cur = nxt; cA = nA; cB = nB; ++ui;
        if constexpr (ALIGN_EPI) { if (wr == 1) PG8_BAR; }
    }
    PG8_WAIT_V(0);
    if constexpr (!ALIGN_EPI) { if (wr == 0) PG8_BAR; }
    PG8_BAR;
    if constexpr (Epi::AFTER_DRAIN) { E.fused(acc, cur, wr, wc, fr, fq, lds, wid, lane); S.done(cur); }
#undef PG8_SA
#undef PG8_SB
#undef PG8_STAGE
#undef PG8_LDA
#undef PG8_LDB
#undef PG8_MMA
#undef PG8_WAIT_V
#undef PG8_WAIT_L
#undef PG8_BAR
#undef PG8_SCHED
}
}
namespace att {
using bf16=__hip_bfloat16;
using bf16x8=__attribute__((ext_vector_type(8)))short;
using s16x4=__attribute__((ext_vector_type(4)))short;
using f32x16=__attribute__((ext_vector_type(16)))float;
using u32x4=__attribute__((ext_vector_type(4)))unsigned;
constexpr int D=64, QP=QKVN  , OP=DM  ;
constexpr int NW=8,QBLK=32,QB=QBLK*NW,KVBLK=64;
__device__ __forceinline__ int crow(int r,int hi){return (r&3)+8*(r>>2)+4*hi;}
#define SBAR() __builtin_amdgcn_sched_barrier(0)
struct UnitP { int qrow0, qcol, kcol, vcol, ocol, ctxrow0, latrow0, NT, mode, r0, rlo; const float* rpb; };

constexpr int NSLOT=3, SLOTB=8192;
constexpr int LDS_K=0, LDS_V=NSLOT*SLOTB, LDS_WS=2*NSLOT*SLOTB, LDS_OST=LDS_WS+NW*64*4, LDS_BIAS=LDS_OST+NW*4096, LDS_BYTES=LDS_BIAS+640*4;
__device__ __forceinline__ void glds16(const void*gsrc,unsigned lds_dst){unsigned keep;
  asm volatile("s_mov_b32 %0, m0\n\ts_mov_b32 m0, %2\n\ts_nop 0\n\tglobal_load_lds_dwordx4 %1, off\n\ts_mov_b32 m0, %0":"=&s"(keep):"v"(gsrc),"s"(lds_dst):"memory");}
__device__ __forceinline__ float max3f(float a,float b,float c){float r;asm("v_max3_f32 %0, %1, %2, %3":"=v"(r):"v"(a),"v"(b),"v"(c));return r;}
__device__ __forceinline__ float max2f(float a,float b){float r;asm("v_max_f32_e32 %0, %1, %2":"=v"(r):"v"(a),"v"(b));return r;}
__device__ __forceinline__ float fadd_s(float a,float b){float r;asm("v_add_f32_e32 %0, %1, %2":"=v"(r):"v"(a),"v"(b));return r;}
__device__ __forceinline__ float fsub_s(float a,float b){float r;asm("v_sub_f32_e32 %0, %1, %2":"=v"(r):"v"(a),"v"(b));return r;}
typedef float f32x2_t __attribute__((ext_vector_type(2))); typedef __bf16 bf16x2_t __attribute__((ext_vector_type(2)));
__device__ __forceinline__ unsigned cvtpk_s(float lo,float hi){f32x2_t v={lo,hi};bf16x2_t b=__builtin_convertvector(v,bf16x2_t);return __builtin_bit_cast(unsigned,b);}
#define WAIT_BAR(N) asm volatile("s_waitcnt vmcnt(" #N ") lgkmcnt(0)\n\ts_barrier":::"memory")

__device__ __forceinline__ void qkt(f32x16&p0,f32x16&p1,const char*Kslot,const bf16x8*qr,const f32x16&negm,int r32,int hi){
  const char*kb=Kslot+hi*1024+r32*16;
  #pragma unroll
  for(int d0=0;d0<4;++d0){
    const bf16x8 b0=*reinterpret_cast<const bf16x8*>(kb+d0*2048);
    const bf16x8 b1=*reinterpret_cast<const bf16x8*>(kb+d0*2048+512);
    if(d0==0){p0=__builtin_amdgcn_mfma_f32_32x32x16_bf16(b0,qr[0],negm,0,0,0);p1=__builtin_amdgcn_mfma_f32_32x32x16_bf16(b1,qr[0],negm,0,0,0);}
    else{p0=__builtin_amdgcn_mfma_f32_32x32x16_bf16(b0,qr[d0],p0,0,0,0);p1=__builtin_amdgcn_mfma_f32_32x32x16_bf16(b1,qr[d0],p1,0,0,0);}}
}
typedef __attribute__((address_space(3))) const char* lds_cptr;
typedef short v4i16_t __attribute__((ext_vector_type(4)));
__device__ __forceinline__ void kload8(bf16x8*kf,lds_cptr kp){
  kf[0]=*(const __attribute__((address_space(3))) bf16x8*)(kp);      kf[1]=*(const __attribute__((address_space(3))) bf16x8*)(kp+512);
  kf[2]=*(const __attribute__((address_space(3))) bf16x8*)(kp+2048); kf[3]=*(const __attribute__((address_space(3))) bf16x8*)(kp+2560);
  kf[4]=*(const __attribute__((address_space(3))) bf16x8*)(kp+4096); kf[5]=*(const __attribute__((address_space(3))) bf16x8*)(kp+4608);
  kf[6]=*(const __attribute__((address_space(3))) bf16x8*)(kp+6144); kf[7]=*(const __attribute__((address_space(3))) bf16x8*)(kp+6656);
}
__device__ __forceinline__ void kload2(bf16x8*kf,lds_cptr kp,int j){ kf[2*j]=*(const __attribute__((address_space(3))) bf16x8*)(kp+j*2048); kf[2*j+1]=*(const __attribute__((address_space(3))) bf16x8*)(kp+j*2048+512); }
__device__ __forceinline__ s16x4 vtr(lds_cptr p){ return __builtin_bit_cast(s16x4,__builtin_amdgcn_ds_read_tr16_b64_v4i16((__attribute__((address_space(3))) v4i16_t*)p)); }
__device__ __forceinline__ float rowmax(const f32x16&p0,const f32x16&p1){
  float a=max3f(p0[0],p0[1],p1[0]),b=max3f(p0[2],p0[3],p1[1]);a=max3f(a,p1[2],p1[3]);
  #pragma unroll
  for(int r=4;r<16;r+=4){a=max3f(a,p0[r],p0[r+1]);b=max3f(b,p0[r+2],p0[r+3]);a=max3f(a,p1[r],p1[r+1]);b=max3f(b,p1[r+2],p1[r+3]);}
  const float m=max2f(a,b);
  auto rr=__builtin_amdgcn_permlane32_swap(__float_as_uint(m),__float_as_uint(m),false,false);
  return max2f(__uint_as_float(rr[0]),__uint_as_float(rr[1]));
}
__device__ __forceinline__ void pv(f32x16*o,int vb,bf16x8 pa0,bf16x8 pa1,bf16x8 pa2,bf16x8 pa3){
  #pragma unroll
  for(int d0=0;d0<2;++d0){s16x4 lo[4],hi[4];
    #pragma unroll
    for(int ks=0;ks<4;++ks){
      asm volatile("ds_read_b64_tr_b16 %0,%1 offset:%c2":"=&v"(lo[ks]):"v"(vb),"i"(d0*4096+ks*1024):"memory");
      asm volatile("ds_read_b64_tr_b16 %0,%1 offset:%c2":"=&v"(hi[ks]):"v"(vb),"i"(d0*4096+ks*1024+512):"memory");}
    asm volatile("s_waitcnt lgkmcnt(0)":::"memory");SBAR();
    #define PK(k) (bf16x8){lo[k][0],lo[k][1],lo[k][2],lo[k][3],hi[k][0],hi[k][1],hi[k][2],hi[k][3]}
    o[d0]=__builtin_amdgcn_mfma_f32_32x32x16_bf16(pa0,PK(0),o[d0],0,0,0);
    o[d0]=__builtin_amdgcn_mfma_f32_32x32x16_bf16(pa1,PK(1),o[d0],0,0,0);
    o[d0]=__builtin_amdgcn_mfma_f32_32x32x16_bf16(pa2,PK(2),o[d0],0,0,0);
    o[d0]=__builtin_amdgcn_mfma_f32_32x32x16_bf16(pa3,PK(3),o[d0],0,0,0);
    #undef PK
  }
}

#ifndef ATTN_STORE16
#define ATTN_STORE16(p,v) (*(__attribute__((address_space(1))) u32x4*)(p)=(v))
#endif
template<int THRL,int MODE> __device__ __forceinline__ void attn_unit(const UnitP&P,const bf16*__restrict__ QKV,bf16*O,char*shm){
  int tid_=threadIdx.x; asm volatile("":"+v"(tid_));
  const int tid=tid_,lane=tid&63,r32=lane&31,hi=lane>>5; const int wid=__builtin_amdgcn_readfirstlane(tid>>6);
  const bf16*Qw=QKV+(long)(P.qrow0+wid*QBLK)*QP+P.qcol;
  const int ctxrow0=P.ctxrow0, latrow0=P.latrow0-4*KVBLK;
  #define KROW(t) (((t)<4?ctxrow0:latrow0)+KVBLK*(t))
  const unsigned lds0=(unsigned)(uintptr_t)shm;
  __attribute__((address_space(3))) float*wsf=(__attribute__((address_space(3))) float*)((__attribute__((address_space(3))) char*)shm+LDS_WS)+wid*64;
  const bf16*ksrc=QKV+(long)lane*QP+P.kcol+wid*8;
  const bf16*vsrc=QKV+(long)(16*(wid&3)+(lane>>2))*QP+P.vcol+(wid>>2)*32+(lane&3)*8;
  const unsigned kdst=lds0+LDS_K+wid*1024, vdst=lds0+LDS_V+wid*1024;
  #define DMA_K(t,slot) glds16(ksrc+(long)KROW(t)*QP,(unsigned)__builtin_amdgcn_readfirstlane(kdst+(slot)))
  #define DMA_V(t,slot) glds16(vsrc+(long)KROW(t)*QP,(unsigned)__builtin_amdgcn_readfirstlane(vdst+(slot)))
  const int vb0=(int)(lds0+LDS_V)+((lane>>4)&1)*32+(lane&3)*8+(4*hi+((lane&15)>>2))*64;
  const char*Kbase=shm+LDS_K; bf16x8 kf[8];
  const lds_cptr shm3=(lds_cptr)shm; const lds_cptr kp0=shm3+LDS_K+hi*1024+r32*16; const lds_cptr vp0=shm3+LDS_V+((lane>>4)&1)*32+(lane&3)*8+(4*hi+((lane&15)>>2))*64;
  const int NT=P.NT;
  DMA_K(0,0);DMA_V(0,0);DMA_K(1,SLOTB);
  bf16x8 qr[4];
  #pragma unroll
  for(int d0=0;d0<4;++d0)qr[d0]=*(const __attribute__((address_space(1))) bf16x8*)(&Qw[(long)r32*QP+d0*16+hi*8]);
  float mhat=0.f,l_reg=0.f;f32x16 o[2];o[0]=f32x16{};o[1]=f32x16{};f32x16 negm=f32x16{};asm volatile("":"+v"(negm));
  const int qrg=P.r0+(wid>>1), qc=32*(wid&1)+r32; int rs_=qrg-4; rs_=rs_<0?0:(rs_>24?24:rs_); int cs_=qc-8; cs_=cs_<0?0:(cs_>48?48:cs_);
  unsigned cm0=0u,cm1=0u;
  if(MODE==1){
    _Pragma("unroll") for(int r=0;r<16;++r){const int k0=crow(r,hi),k1=k0+32; cm0|=(unsigned)(k0>=cs_&&k0<=cs_+15)<<r; cm1|=(unsigned)(k1>=cs_&&k1<=cs_+15)<<r;}
    __attribute__((address_space(3))) float*bt=(__attribute__((address_space(3))) float*)((__attribute__((address_space(3))) char*)shm+LDS_BIAS); for(int i=tid;i<465;i+=512)bt[64+i]=P.rpb[i]*1.4426950408889634f; }
  const __attribute__((address_space(3))) float*bbase=(const __attribute__((address_space(3))) float*)((__attribute__((address_space(3))) char*)shm+LDS_BIAS)+64+15-qc+4*hi;
  const int rlo_=P.rlo;
  #define CMASK(P0,P1,t) do{ if(MODE==1&&(t)>=4){ const int kr_=rlo_+(t)-4; const bool rok_=(kr_>=rs_)&&(kr_<=rs_+7); int dr_=kr_-qrg+7; dr_=dr_<0?0:(dr_>14?14:dr_); \
      const __attribute__((address_space(3))) float*br_=bbase+dr_*31; const unsigned m0_=rok_?cm0:0u, m1_=rok_?cm1:0u; \
      _Pragma("unroll") for(int r=0;r<16;++r){ const int ko_=(r&3)+8*(r>>2); \
        P0[r]=((m0_>>r)&1u)?P0[r]+br_[ko_]:-INFINITY; P1[r]=((m1_>>r)&1u)?P1[r]+br_[ko_+32]:-INFINITY; } } }while(0)
  bool resc=false;
  #define START(P0,P1) do{ const float rm=rowmax(P0,P1); resc=false; \
    { const float dl=rm; mhat=fadd_s(mhat,dl); \
      _Pragma("unroll") for(int r=0;r<16;++r){P0[r]=fsub_s(P0[r],dl);P1[r]=fsub_s(P1[r],dl);} \
      _Pragma("unroll") for(int r=0;r<16;++r)negm[r]=-mhat; asm volatile("":"+v"(negm)); } \
    _Pragma("unroll") for(int r=0;r<16;++r)P0[r]=__builtin_amdgcn_exp2f(P0[r]); }while(0)
  #define RESC() do{ if(resc){ asm volatile("s_waitcnt lgkmcnt(0)":::"memory"); \
      _Pragma("unroll") for(int d_=0;d_<2;++d_) _Pragma("unroll") for(int r=0;r<16;++r)o[d_][r]*=wsf[crow(r,hi)]; } }while(0)
  f32x16 pA0,pA1,pB0,pB1;
  int sl_prev=0,sl_cur=0,sl_next=SLOTB;
  #define ROT() do{sl_prev=sl_cur;sl_cur=sl_next;sl_next=(sl_next==(NSLOT-1)*SLOTB)?0:sl_next+SLOTB;}while(0)
  DMA_K(2,2*SLOTB);
  WAIT_BAR(3);
  qkt(pA0,pA1,Kbase,qr,negm,r32,hi);asm volatile("s_nop 15\n\ts_nop 7":"+v"(pA0),"+v"(pA1));CMASK(pA0,pA1,0);
  START(pA0,pA1);
  _Pragma("unroll") for(int r=0;r<16;++r)pA1[r]=__builtin_amdgcn_exp2f(pA1[r]);
  WAIT_BAR(0);
  DMA_K(3,0);DMA_V(1,SLOTB);
  ROT();
  kload8(kf,kp0+sl_cur);
  WAIT_BAR(2);
  s16x4 vlo[8],vhi[8]; u32x4 pw0,pw1,pw2,pw3;
  #define PKW(P,B) cvtpk_s(P[B],P[B+1])
  #define PAF(k) __builtin_bit_cast(bf16x8,pw##k)
  #define VFR(i) (bf16x8){vlo[i][0],vlo[i][1],vlo[i][2],vlo[i][3],vhi[i][0],vhi[i][1],vhi[i][2],vhi[i][3]}
  #define PIN(x) asm volatile("":"+v"(x))
  #define MX3(a,b,c) __builtin_fmaxf(__builtin_fmaxf((a),(b)),(c))
  #define GAPA(MF,A0,A1,A2,A3,W0,W1,PW) do{ MF; sacc+=A0; sacc+=A1; sacc+=A2; sacc+=A3; PIN(sacc); W0; W1; PIN(PW); SBAR(); }while(0)
  #define EX(v) __builtin_amdgcn_exp2f(v)
  #define GAPB(MF,X,B) do{ MF; X[B]=EX(X[B]); X[B+1]=EX(X[B+1]); X[B+2]=EX(X[B+2]); X[B+3]=EX(X[B+3]); PIN(X); SBAR(); }while(0)
  #define VRD(i) do{ vlo[i]=vtr(vp_+(((i)>>2)*4096+((i)&3)*1024)); vhi[i]=vtr(vp_+(((i)>>2)*4096+((i)&3)*1024+512)); }while(0)
  #define KRD(G,j) do{ if(G){ kload2(kf,kp0+sl_next,j); SBAR(); } }while(0)
  #define STEP(C0,C1,P0,P1,t,GK,GV,GL) do{ SBAR(); \
    const lds_cptr vp_=vp0+sl_prev; \
    VRD(0); SBAR(); float sacc=(P0[0]+P0[1]); \
    GAPA(C0=__builtin_amdgcn_mfma_f32_32x32x16_bf16(kf[0],qr[0],negm,0,0,0), P0[2],P0[3],P0[4],P0[5],     pw0[0]=PKW(P0,0), pw0[1]=PKW(P0,2), pw0); \
    VRD(4); SBAR(); GAPA(C1=__builtin_amdgcn_mfma_f32_32x32x16_bf16(kf[1],qr[0],negm,0,0,0), P0[6],P0[7],P0[8],P0[9],     pw0[2]=PKW(P0,4), pw0[3]=PKW(P0,6), pw0); \
    VRD(1); SBAR(); GAPA(C0=__builtin_amdgcn_mfma_f32_32x32x16_bf16(kf[2],qr[1],C0,0,0,0),   P0[10],P0[11],P0[12],P0[13], pw1[0]=PKW(P0,8), pw1[1]=PKW(P0,10), pw1); \
    VRD(5); SBAR(); GAPA(C1=__builtin_amdgcn_mfma_f32_32x32x16_bf16(kf[3],qr[1],C1,0,0,0),   P0[14],P0[15],P1[0],P1[1],   pw1[2]=PKW(P0,12),pw1[3]=PKW(P0,14), pw1); \
    VRD(2); SBAR(); GAPA(C0=__builtin_amdgcn_mfma_f32_32x32x16_bf16(kf[4],qr[2],C0,0,0,0),   P1[2],P1[3],P1[4],P1[5],     pw2[0]=PKW(P1,0), pw2[1]=PKW(P1,2), pw2); \
    VRD(6); SBAR(); GAPA(C1=__builtin_amdgcn_mfma_f32_32x32x16_bf16(kf[5],qr[2],C1,0,0,0),   P1[6],P1[7],P1[8],P1[9],     pw2[2]=PKW(P1,4), pw2[3]=PKW(P1,6), pw2); \
    VRD(3); SBAR(); GAPA(C0=__builtin_amdgcn_mfma_f32_32x32x16_bf16(kf[6],qr[3],C0,0,0,0),   P1[10],P1[11],P1[12],P1[13], pw3[0]=PKW(P1,8), pw3[1]=PKW(P1,10), pw3); \
    VRD(7); SBAR(); GAPA(C1=__builtin_amdgcn_mfma_f32_32x32x16_bf16(kf[7],qr[3],C1,0,0,0),   P1[14],P1[15],0.f,0.f,       pw3[2]=PKW(P1,12),pw3[3]=PKW(P1,14), pw3); \
    l_reg+=sacc; \
    if(GK){DMA_K((t)+3,sl_cur);} if(GV){DMA_V((t)+1,sl_next);} \
    CMASK(C0,C1,t); \
    { float a=MX3(C0[0],C0[1],C1[0]),b=MX3(C0[2],C0[3],C1[1]); a=MX3(a,C1[2],C1[3]); \
      _Pragma("unroll") for(int r=4;r<16;r+=4){a=MX3(a,C0[r],C0[r+1]);b=MX3(b,C0[r+2],C0[r+3]);a=MX3(a,C1[r],C1[r+1]);b=MX3(b,C1[r+2],C1[r+3]);} \
      float rm=__builtin_fmaxf(a,b); { auto rr=__builtin_amdgcn_permlane32_swap(__float_as_uint(rm),__float_as_uint(rm),false,false); rm=__builtin_fmaxf(__uint_as_float(rr[0]),__uint_as_float(rr[1])); } \
      resc=false; \
      if(__builtin_expect(__any(rm>(float)THRL),0)){ const float dl=__builtin_fmaxf(rm,0.f); mhat+=dl; \
        _Pragma("unroll") for(int r=0;r<16;++r){C0[r]-=dl;C1[r]-=dl;} \
        _Pragma("unroll") for(int r=0;r<16;++r)negm[r]=-mhat; asm volatile("":"+v"(negm)); \
        const float f=__builtin_amdgcn_exp2f(-dl); l_reg*=f; if(hi==0)wsf[r32]=f; resc=true; } } \
    SBAR(); \
    GAPB(o[0]=__builtin_amdgcn_mfma_f32_32x32x16_bf16(PAF(0),VFR(0),o[0],0,0,0), C0,0); \
    GAPB(o[1]=__builtin_amdgcn_mfma_f32_32x32x16_bf16(PAF(0),VFR(4),o[1],0,0,0), C0,4); \
    KRD(GL,0); GAPB(o[0]=__builtin_amdgcn_mfma_f32_32x32x16_bf16(PAF(1),VFR(1),o[0],0,0,0), C0,8); \
    KRD(GL,1); GAPB(o[1]=__builtin_amdgcn_mfma_f32_32x32x16_bf16(PAF(1),VFR(5),o[1],0,0,0), C0,12); \
    KRD(GL,2); GAPB(o[0]=__builtin_amdgcn_mfma_f32_32x32x16_bf16(PAF(2),VFR(2),o[0],0,0,0), C1,0); \
    KRD(GL,3); GAPB(o[1]=__builtin_amdgcn_mfma_f32_32x32x16_bf16(PAF(2),VFR(6),o[1],0,0,0), C1,4); \
    GAPB(o[0]=__builtin_amdgcn_mfma_f32_32x32x16_bf16(PAF(3),VFR(3),o[0],0,0,0), C1,8); \
    GAPB(o[1]=__builtin_amdgcn_mfma_f32_32x32x16_bf16(PAF(3),VFR(7),o[1],0,0,0), C1,12); \
    }while(0)
  int t=1;
  for(;t+5<NT;t+=2){
    STEP(pB0,pB1,pA0,pA1,t,true,true,true);     WAIT_BAR(2); RESC(); ROT();
    STEP(pA0,pA1,pB0,pB1,t+1,true,true,true);   WAIT_BAR(2); RESC(); ROT();
  }
  #define ENDW(tt) do{ if((tt)+3<NT){WAIT_BAR(2);} else if((tt)+2<NT){WAIT_BAR(1);} else {WAIT_BAR(0);} }while(0)
  for(;t+1<NT;t+=2){
    STEP(pB0,pB1,pA0,pA1,t,(t+3<NT),(t+1<NT),(t+1<NT));       ENDW(t);   RESC(); ROT();
    STEP(pA0,pA1,pB0,pB1,t+1,(t+4<NT),(t+2<NT),(t+2<NT));     ENDW(t+1); RESC(); ROT();
  }
  STEP(pB0,pB1,pA0,pA1,NT-1,false,false,false); RESC();
  { float sacc=pB0[0]+pB0[1]; _Pragma("unroll") for(int r=2;r<16;++r)sacc+=pB0[r]; _Pragma("unroll") for(int r=0;r<16;++r)sacc+=pB1[r]; l_reg+=sacc;
    pw0=(u32x4){PKW(pB0,0),PKW(pB0,2),PKW(pB0,4),PKW(pB0,6)};pw1=(u32x4){PKW(pB0,8),PKW(pB0,10),PKW(pB0,12),PKW(pB0,14)};pw2=(u32x4){PKW(pB1,0),PKW(pB1,2),PKW(pB1,4),PKW(pB1,6)};pw3=(u32x4){PKW(pB1,8),PKW(pB1,10),PKW(pB1,12),PKW(pB1,14)};
    SBAR(); pv(o,vb0+sl_cur,PAF(0),PAF(1),PAF(2),PAF(3)); }
  #undef PKW
  #undef PAF
  #undef VFR
  #undef PIN
  #undef MX3
  #undef GAPA
  #undef GAPB
  #undef EX
  #undef VRD
  #undef KRD
  #undef STEP
  #undef ENDW
  {auto rr=__builtin_amdgcn_permlane32_swap(__float_as_uint(l_reg),__float_as_uint(l_reg),false,false);l_reg=__uint_as_float(rr[0])+__uint_as_float(rr[1]);}
  if(hi==0)wsf[32+r32]=l_reg;asm volatile("s_waitcnt lgkmcnt(0)":::"memory");
  float rli[16];
  #pragma unroll
  for(int r=0;r<16;++r)rli[r]=__builtin_amdgcn_rcpf(wsf[32+crow(r,hi)]);
  bf16*Ow=O+(long)(P.qrow0+wid*QBLK)*OP+P.ocol;
  { __attribute__((address_space(3))) unsigned short*stg=(__attribute__((address_space(3))) unsigned short*)((__attribute__((address_space(3))) char*)shm+LDS_OST)+wid*2048;
    #pragma unroll
    for(int r=0;r<16;++r){const int orow=crow(r,hi);
      #pragma unroll
      for(int d0=0;d0<2;++d0)stg[orow*64+d0*32+r32]=(unsigned short)(cvtpk_s(o[d0][r]*rli[r],0.f)&0xffffu);}
    asm volatile("s_waitcnt lgkmcnt(0)":::"memory");
    #pragma unroll
    for(int i=0;i<4;++i){const int row=i*8+(lane>>3),ch=lane&7; const u32x4 v=*(const __attribute__((address_space(3))) u32x4*)(stg+row*64+ch*8); ATTN_STORE16(Ow+(long)row*OP+ch*8,v);} }
  asm volatile("s_waitcnt lgkmcnt(0)\n\ts_barrier":::"memory");
  #undef DMA_K
  #undef DMA_V
  #undef CMASK
  #undef START
  #undef RESC
  #undef ROT
  #undef KROW
}

constexpr int ATTN_LDS_BYTES=LDS_BYTES;
__device__ __forceinline__ void make_unit(int u, int layer, const float* rpb_all, UnitP& P) {
    P.r0 = 0; P.rlo = 0; P.rpb = rpb_all; P.mode = 0;
    if (u < 512) { const int b = u >> 6, hq = (u >> 3) & 7, qb = u & 7;
        P.qrow0 = b * SEQ + 256 * qb; P.qcol = 1536 + 64 * hq; P.kcol = 2048 + 64 * (hq >> 2); P.vcol = 2176 + 64 * (hq >> 2); P.ocol = 512 + 64 * hq;
        P.ctxrow0 = NLAT + b * CTXL; P.latrow0 = b * SEQ; P.NT = 36; }
    else if (u < 1024) { const int v = u - 512, b = v >> 6, h = (v >> 3) & 7, g = v & 7;
        P.qrow0 = b * SEQ + 256 * g; P.qcol = 64 * h; P.kcol = 512 + 64 * h; P.vcol = 1024 + 64 * h; P.ocol = 64 * h;
        P.ctxrow0 = NLAT + b * CTXL; P.r0 = 4 * g;
        int rlo = 4 * g - 4; rlo = rlo < 0 ? 0 : (rlo > 24 ? 24 : rlo); int rhs = 4 * g + 3 - 4; rhs = rhs < 0 ? 0 : (rhs > 24 ? 24 : rhs); const int rhi = rhs + 7;
        P.rlo = rlo; P.latrow0 = b * SEQ + 64 * rlo; const int nt = 4 + (rhi - rlo + 1); P.NT = nt + (nt & 1); P.mode = 1; P.rpb = rpb_all + (size_t)(layer * 8 + h) * 15 * 31; }
    else { const int v = u - 1024, b = v >> 4, h16 = v & 15;
        P.qrow0 = NLAT + b * CTXL; P.ctxrow0 = NLAT + b * CTXL; P.latrow0 = 0; P.NT = 4;
        if (h16 < 8) { P.qcol = 64 * h16; P.kcol = 512 + 64 * h16; P.vcol = 1024 + 64 * h16; P.ocol = 64 * h16; }
        else { const int hq = h16 - 8; P.qcol = 1536 + 64 * hq; P.kcol = 2048 + 64 * (hq >> 2); P.vcol = 2176 + 64 * (hq >> 2); P.ocol = 512 + 64 * hq; } }
}
#undef SBAR
#undef WAIT_BAR
}
#define GAS __attribute__((address_space(1)))
#define LAS __attribute__((address_space(3)))
typedef unsigned short bf16;
typedef unsigned v4u __attribute__((ext_vector_type(4)));
typedef float f32x4 __attribute__((ext_vector_type(4)));
constexpr int NWAVES = 8;
constexpr int LDS_BYTES = 147456;
constexpr size_t MiB = 1u << 20;
constexpr size_t WS_CTL = 0;
constexpr size_t WS_MOD = 1 * MiB;
constexpr size_t WS_ROPE = WS_MOD + 960 * 1024;
constexpr size_t WS_W = 2 * MiB;
constexpr size_t W_IN = 0, W_OUT = (size_t)QKVN * DM * 2, W_GU = W_OUT + (size_t)DM * DM * 2, W_DN = W_GU + (size_t)GUN * DM * 2, W_LAYER = W_DN + (size_t)DM * FF * 2;
static_assert(W_LAYER == 23 * MiB, "weights per layer");
constexpr size_t WS_CTXB = 94 * MiB;
constexpr size_t WS_XN = 102 * MiB;
constexpr size_t WS_QKV = 138 * MiB;
constexpr size_t WS_O = 219 * MiB;
constexpr size_t WS_H = 138 * MiB;
constexpr size_t WS_ADAP = 138 * MiB;
constexpr size_t WS_END = 255 * MiB;
static_assert(WS_W + 4 * W_LAYER <= WS_CTXB && WS_QKV + (size_t)NROWS * QKVN * 2 <= WS_O && WS_O + (size_t)NROWS * DM * 2 <= WS_END && WS_H + (size_t)NROWS * FF * 2 <= WS_END, "ws map");

__device__ __forceinline__ unsigned f2bf(float f) { unsigned u = __builtin_bit_cast(unsigned, f); return (u + 0x7fffu + ((u >> 16) & 1u)) >> 16; }
__device__ __forceinline__ unsigned pk2(float lo, float hi) { return f2bf(lo) | (f2bf(hi) << 16); }
__device__ __forceinline__ float wave_sum(float v) {
#pragma unroll
    for (int o = 1; o < 64; o <<= 1) v += __shfl_xor(v, o);
    return v;
}
__device__ __forceinline__ void transpose_item(const float* W, int K, int N, bf16* WT, int k0, int n0, int drow0, LAS float* scr, int lane) {
#pragma unroll 8
    for (int i = 0; i < 32; ++i) { const int kk = 2 * i + (lane >> 5); scr[kk * 33 + (lane & 31)] = W[(size_t)(k0 + kk) * N + n0 + (lane & 31)]; }
    asm volatile("s_waitcnt lgkmcnt(0)" ::: "memory");
    const int c = lane & 7;
#pragma unroll
    for (int j = 0; j < 4; ++j) { const int n = (lane >> 3) + 8 * j; const LAS float* s = scr + (8 * c) * 33 + n;
        v4u o; o.x = pk2(s[0 * 33], s[1 * 33]); o.y = pk2(s[2 * 33], s[3 * 33]); o.z = pk2(s[4 * 33], s[5 * 33]); o.w = pk2(s[6 * 33], s[7 * 33]);
        *(v4u*)(WT + (size_t)(drow0 + n) * K + k0 + 8 * c) = o; }
    asm volatile("s_waitcnt lgkmcnt(0)" ::: "memory");
}

typedef GAS unsigned gu32;
#define RLX_AGENT __ATOMIC_RELAXED, __HIP_MEMORY_SCOPE_AGENT
constexpr int RING_BYTES = 131072, LDSCTL_OFF = RING_BYTES, MISC_OFF = LDSCTL_OFF + 320;
constexpr int CW_BAR = 4096;
constexpr size_t CTL_ZERO_BYTES = 256 * 1024;
#define XB_TMO      128
#define XB_XCNT(j)  (256  + 64 * (j))
#define XB_XSUB(j)  (1280 + 64 * (j))
#define XB_XGEN(j)  (2304 + 64 * (j))
#define XB_TOP      3328
#define XB_TOPGEN   3392
#define XCD_BAR_WORDS 3456
#define XB_SPIN_CAP (1u << 18)

__device__ __forceinline__ unsigned xb_ld(unsigned* p)              { return __hip_atomic_load(p, __ATOMIC_RELAXED, __HIP_MEMORY_SCOPE_AGENT); }
__device__ __forceinline__ unsigned xb_add(unsigned* p, unsigned v) { return __hip_atomic_fetch_add(p, v, __ATOMIC_RELAXED, __HIP_MEMORY_SCOPE_AGENT); }
__device__ __forceinline__ unsigned xb_xcc_id() { return (unsigned)__builtin_amdgcn_s_getreg((3 << 11) | 20) & 0xFu; }
#define XB_SPIN(cond, bar) do { unsigned _sp = 0; while (cond) { __builtin_amdgcn_s_sleep(1); \
    if ((++_sp & 255u) == 0u) { if (xb_ld(&(bar)[XB_TMO])) break; if (_sp > XB_SPIN_CAP) { atomicAdd(&(bar)[XB_TMO], 1u); break; } } } } while (0)

struct XcdBarrier {
    unsigned* bar; unsigned x;
    volatile LAS unsigned* st;
};

__device__ __forceinline__ XcdBarrier xcd_barrier_post(unsigned* bar, volatile LAS unsigned* st) {
    XcdBarrier b; b.bar = bar; b.x = xb_xcc_id(); b.st = st;
    if (threadIdx.x == 0) (void)xb_add(&bar[XB_XCNT(b.x)], 1u);
    return b;
}
__device__ __forceinline__ void xcd_barrier_complete(unsigned* bar, unsigned x, unsigned& nloc, unsigned& nx) {
    const unsigned G = gridDim.x * gridDim.y * gridDim.z;
    unsigned sum, cnt, mine, sp = 0u;
    for (;;) {
        sum = 0u; cnt = 0u; mine = 0u;
#pragma unroll
        for (unsigned j = 0; j < 16; ++j) { const unsigned c = xb_ld(&bar[XB_XCNT(j)]); sum += c; cnt += (c > 0u) ? 1u : 0u; mine = (j == x) ? c : mine; }
        if (sum == G) break;
        __builtin_amdgcn_s_sleep(1);
        if ((++sp & 255u) == 0u) { if (xb_ld(&bar[XB_TMO])) break; if (sp > XB_SPIN_CAP) { atomicAdd(&bar[XB_TMO], 1u); break; } }
    }
    nloc = mine > 0u ? mine : 1u; nx = cnt > 0u ? cnt : 1u;
}

__device__ __forceinline__ void xcd_barrier(const XcdBarrier& b) {
    asm volatile("s_waitcnt vmcnt(0)" ::: "memory");
    __syncthreads();
    if (threadIdx.x == 0) {
        unsigned* bar = b.bar;
        __builtin_amdgcn_s_waitcnt(0);
        unsigned nloc = b.st[0], nx = b.st[1];
        if (nloc == 0u) { xcd_barrier_complete(bar, b.x, nloc, nx); b.st[0] = nloc; b.st[1] = nx; }
        const unsigned old = xb_add(&bar[XB_XSUB(b.x)], 1u);
        const unsigned gen = old / nloc;
        if (old + 1u == (gen + 1u) * nloc) {
            __builtin_amdgcn_fence(__ATOMIC_RELEASE, "agent");
            asm volatile("s_waitcnt vmcnt(0)" ::: "memory");
            const unsigned og = xb_add(&bar[XB_TOP], 1u);
            const unsigned tg = og / nx;
            if (og + 1u == (tg + 1u) * nx) xb_add(&bar[XB_TOPGEN], 1u);
            else XB_SPIN(xb_ld(&bar[XB_TOPGEN]) == tg, bar);
            __builtin_amdgcn_fence(__ATOMIC_ACQUIRE, "agent");
            xb_add(&bar[XB_XGEN(b.x)], 1u);
            asm volatile("s_waitcnt vmcnt(0)" ::: "memory");
        } else {
            XB_SPIN(xb_ld(&bar[XB_XGEN(b.x)]) == gen, bar);
            __builtin_amdgcn_fence(__ATOMIC_ACQUIRE, "agent");
            asm volatile("s_waitcnt vmcnt(0)" ::: "memory");
        }
    }
    __syncthreads();
}

#ifndef DUP_ATT
#define DUP_ATT 0
#endif
#ifndef DUP_GEMM
#define DUP_GEMM 0
#endif
#ifndef DUP_MISC
#define DUP_MISC 0
#endif
struct Args { const float* in[18]; float* out; unsigned char* ws; int ph_lo, ph_hi; };
enum { I_X = 0, I_C, I_CTX, I_CCTX, I_WADA, I_BADA, I_ANORM, I_WIN, I_QNA, I_KNA, I_QNB, I_KNB, I_RPB, I_WOUT, I_FNORM, I_WG, I_WU, I_WD };

__device__ __forceinline__ void norm_rows(const float* xlat, const float* xctx, const float* g, const float* modl, int shift_chunk, bf16* XN, int gw, int NGW, int lane) {
    asm volatile("" : "+v"(lane));
    f32x4 gv[4];
#pragma unroll
    for (int j = 0; j < 4; ++j) gv[j] = *((const GAS f32x4*)g + lane + 64 * j);
    for (int row = gw; row < NROWS; row += NGW) {
        const bool lat = row < NLAT; const float* xr = lat ? xlat + (size_t)row * DM : xctx + (size_t)(row - NLAT) * DM;
        const int bidx = lat ? (row >> 11) : 8;
        const float* sh = modl + bidx * 6144 + shift_chunk * 1024; const float* sc = sh + 1024;
        f32x4 v[4]; float ss = 0.f;
#pragma unroll
        for (int j = 0; j < 4; ++j) { v[j] = *((const GAS f32x4*)xr + lane + 64 * j); ss += (v[j][0] * v[j][0] + v[j][1] * v[j][1]) + (v[j][2] * v[j][2] + v[j][3] * v[j][3]); }
        const float rstd = 1.0f / sqrtf(wave_sum(ss) * (1.0f / DM) + EPS);
        GAS unsigned long long* o8 = (GAS unsigned long long*)(XN + (size_t)row * DM) + lane;
#pragma unroll
        for (int j = 0; j < 4; ++j) { const f32x4 s4 = *((const GAS f32x4*)sh + lane + 64 * j), c4 = *((const GAS f32x4*)sc + lane + 64 * j);
            const f32x4 y = (v[j] * rstd * gv[j]) * (c4 + 1.0f) + s4;
            o8[64 * j] = (unsigned long long)pk2(y[0], y[1]) | ((unsigned long long)pk2(y[2], y[3]) << 32); }
    }
}

__global__ void __launch_bounds__(NWAVES * 64, 2) fwd(Args args) {
    extern __shared__ __attribute__((aligned(16))) unsigned char lds_raw[];
    LAS unsigned char* lds = (LAS unsigned char*)lds_raw;
    cg::grid_group grid = cg::this_grid();
    const int tid = threadIdx.x, lane = tid & 63, wave = __builtin_amdgcn_readfirstlane(tid >> 6);
    const int G = gridDim.x, bx = blockIdx.x;
    const int gw = bx * NWAVES + wave, NGW = G * NWAVES;
    unsigned char* ws = args.ws;
    float* MOD = (float*)(ws + WS_MOD); float* ROPEC = (float*)(ws + WS_ROPE); float* ROPES = ROPEC + 1024;
    float* CTXB = (float*)(ws + WS_CTXB); bf16* XN = (bf16*)(ws + WS_XN); bf16* QKV = (bf16*)(ws + WS_QKV); bf16* OB = (bf16*)(ws + WS_O); bf16* HB = (bf16*)(ws + WS_H);
    float* ADAP = (float*)(ws + WS_ADAP);
    float* XOUT = args.out;
    for (int u = tid; u < (LDS_BYTES - LDSCTL_OFF) / 4; u += NWAVES * 64) ((LAS unsigned*)(lds + LDSCTL_OFF))[u] = 0u;
    __syncthreads();
    (void)xcd_barrier_post((unsigned*)(ws + WS_CTL) + CW_BAR, (volatile LAS unsigned*)(lds + MISC_OFF) + 8);
#define SEAM() do { unsigned char* w_ = args.ws; asm volatile("" : "+s"(w_)); XcdBarrier b_; b_.bar = (unsigned*)(w_ + WS_CTL) + CW_BAR; b_.x = xb_xcc_id(); b_.st = (volatile LAS unsigned*)(lds + MISC_OFF) + 8; xcd_barrier(b_); } while (0)

    {
        LAS float* sl = (LAS float*)lds;
        for (int i = tid; i < 9 * 1024; i += NWAVES * 64) { const float c = (i < 8192) ? args.in[I_C][i] : args.in[I_CCTX][i - 8192]; sl[i] = c * __builtin_amdgcn_rcpf(1.0f + __expf(-c)); }
        __syncthreads();
        for (int it = gw; it < 4 * 96 * 8; it += NGW) {
            const int kc = it & 7, cc = (it >> 3) % 96, l = it / 768;
            const float* W = args.in[I_WADA] + (size_t)l * DM * 6144 + (size_t)(kc * 128) * 6144 + cc * 64 + lane;
            float a[9];
#pragma unroll
            for (int i = 0; i < 9; ++i) a[i] = 0.f;
#pragma unroll 2
            for (int k4 = 0; k4 < 32; ++k4) {
                float w[4];
#pragma unroll
                for (int j = 0; j < 4; ++j) w[j] = W[(size_t)(k4 * 4 + j) * 6144];
#pragma unroll
                for (int i = 0; i < 9; ++i) { const f32x4 s4 = *(const LAS f32x4*)(sl + i * 1024 + kc * 128 + k4 * 4); a[i] += (s4[0] * w[0] + s4[1] * w[1]) + (s4[2] * w[2] + s4[3] * w[3]); }
            }
#pragma unroll
            for (int i = 0; i < 9; ++i) ADAP[((size_t)(kc * 4 + l) * 9 + i) * 6144 + cc * 64 + lane] = a[i];
        }
        LAS float* scr = (LAS float*)(lds + 36864 + wave * 8448);
        constexpr int IT_IN = 16 * 72, IT_OUT = 16 * 32, IT_G = 16 * 88, IT_D = 44 * 32, IT_L = IT_IN + IT_OUT + 2 * IT_G + IT_D;
        for (int it = gw; it < 4 * IT_L; it += NGW) {
            const int l = it / IT_L; int r = it % IT_L;
            bf16* WL = (bf16*)(ws + WS_W + (size_t)l * W_LAYER);
            if (r < IT_IN) { const int kb = r / 72, nb = r % 72, n0 = 32 * nb, cl = n0 & 255;
                const int drow0 = (n0 & ~255) + 128 * ((cl & 63) >> 5) + 32 * (cl >> 6);
                transpose_item(args.in[I_WIN] + (size_t)l * DM * QKVN, DM, QKVN, (bf16*)((unsigned char*)WL + W_IN), 64 * kb, n0, drow0, scr, lane); continue; }
            r -= IT_IN;
            if (r < IT_OUT) { const int kb = r / 32, nb = r % 32;
                transpose_item(args.in[I_WOUT] + (size_t)l * DM * DM, DM, DM, (bf16*)((unsigned char*)WL + W_OUT), 64 * kb, 32 * nb, 32 * nb, scr, lane); continue; }
            r -= IT_OUT;
            if (r < 2 * IT_G) { const int up = r >= IT_G; if (up) r -= IT_G; const int kb = r / 88, nb = r % 88, n0 = 32 * nb;
                const int drow0 = 256 * (n0 >> 7) + 128 * up + (n0 & 127);
                transpose_item(args.in[up ? I_WU : I_WG] + (size_t)l * DM * FF, DM, FF, (bf16*)((unsigned char*)WL + W_GU), 64 * kb, n0, drow0, scr, lane); continue; }
            r -= 2 * IT_G;
            { const int kb = r / 32, nb = r % 32;
                transpose_item(args.in[I_WD] + (size_t)l * FF * DM, FF, DM, (bf16*)((unsigned char*)WL + W_DN), 64 * kb, 32 * nb, 32 * nb, scr, lane); }
        }
        for (int i = gw * 64 + lane; i < NCTX * DM / 4; i += NGW * 64) ((f32x4*)CTXB)[i] = ((const f32x4*)args.in[I_CTX])[i];
        if (bx == 0 && tid < 16) {
            const double cb[16] = {0.5403023058681398, 0.8460091102817079, 0.9504152802551828, 0.9842302344700946, 0.9950041652780258, 0.9984192777926645, 0.9995000416652778, 0.9998418902836144,
                                   0.9999500004166653, 0.9999841886533658, 0.9999950000041666, 0.9999984188615866, 0.9999995000000417, 0.9999998418861211, 0.9999999500000004, 0.9999999841886117};
            const double sb[16] = {0.8414709848078965, 0.5331684399140229, 0.31098359290718575, 0.17689218624615005, 0.09983341664682815, 0.05620449921469249, 0.03161750640243371, 0.01778185687966613,
                                   0.009999833334166664, 0.005623383613960186, 0.0031622723897082477, 0.0017782784728035289, 0.0009999998333333417, 0.0005623412955523594, 0.0003162277607463752, 0.00017782794006665674};
            double c1 = 1.0, s1 = 0.0, cf = 1.0, sf = 0.0;
#pragma unroll
            for (int i = 0; i < 16; ++i) if (i == tid) { cf = cb[i]; sf = sb[i]; }
            for (int p = 0; p < 64; ++p) { ROPEC[p * 16 + tid] = (float)c1; ROPES[p * 16 + tid] = (float)s1; const double cn = c1 * cf - s1 * sf, sn = s1 * cf + c1 * sf; c1 = cn; s1 = sn; }
        }
    }
    grid.sync();
    for (int e = gw * 64 + lane; e < 4 * 9 * 6144; e += NGW * 64) {
        const int n = e % 6144, li = e / 6144, l = li / 9;
        float s = args.in[I_BADA][l * 6144 + n];
#pragma unroll
        for (int kc = 0; kc < 8; ++kc) s += ADAP[(size_t)kc * 4 * 9 * 6144 + e];
        MOD[e] = s;
    }
    SEAM();

    for (int l = 0; l < DEPTH; ++l) {
        unsigned char* ws = args.ws; asm volatile("" : "+s"(ws));
        float* MOD = (float*)(ws + WS_MOD); float* ROPEC = (float*)(ws + WS_ROPE); float* ROPES = ROPEC + 1024;
        float* CTXB = (float*)(ws + WS_CTXB); bf16* XN = (bf16*)(ws + WS_XN); bf16* QKV = (bf16*)(ws + WS_QKV); bf16* OB = (bf16*)(ws + WS_O); bf16* HB = (bf16*)(ws + WS_H);
        float* XOUT = args.out; asm volatile("" : "+s"(XOUT));
        const float* modl = MOD + (size_t)l * 9 * 6144;
        const float* xsrc = (l == 0) ? args.in[I_X] : XOUT;
        const bf16* WL = (const bf16*)(ws + WS_W + (size_t)l * W_LAYER);
        for (int rep = 0; rep <= DUP_MISC; ++rep) norm_rows(xsrc, CTXB, args.in[I_ANORM] + l * DM, modl, 0, XN, gw, NGW, lane);
        SEAM();
        { pg8::Gemm g{XN, (const bf16*)((const unsigned char*)WL + W_IN), NROWS, QKVN, DM}; pg8::StaticOrder S; S.init(NROWS, QKVN, G, bx);
          pg8::EpiQKV E{QKV, args.in[I_QNA] + l * HD, args.in[I_KNA] + l * HD, args.in[I_QNB] + l * HD, args.in[I_KNB] + l * HD, ROPEC, ROPES};
          for (int rep = 0; rep <= DUP_GEMM; ++rep) pg8::gemm_phase<pg8::EpiQKV, pg8::StaticOrder, true, true>(lds, g, S, E); }
        SEAM();
        { const int nunits = 1152;
          for (int rep = 0; rep <= DUP_ATT; ++rep) for (int u = bx; u < nunits; u += G) { att::UnitP P; att::make_unit(u, l, args.in[I_RPB], P);
              if (P.mode == 1) att::attn_unit<8, 1>(P, (const att::bf16*)QKV, (att::bf16*)OB, (char*)lds_raw); else att::attn_unit<8, 0>(P, (const att::bf16*)QKV, (att::bf16*)OB, (char*)lds_raw); } }
        SEAM();
        { pg8::Gemm g{OB, (const bf16*)((const unsigned char*)WL + W_OUT), NROWS, DM, DM}; pg8::StaticOrder S; S.init(NROWS, DM, G, bx);
          pg8::EpiRes E{xsrc, CTXB, XOUT, CTXB, modl + 2 * 1024};
          pg8::gemm_phase<pg8::EpiRes, pg8::StaticOrder, true, true>(lds, g, S, E);
          if (DUP_GEMM) { __syncthreads(); pg8::EpiRes E2{XOUT, CTXB, XOUT, CTXB, (const float*)(ws + WS_CTL + 32768)}; pg8::gemm_phase<pg8::EpiRes, pg8::StaticOrder, true, true>(lds, g, S, E2); } }
        SEAM();
        for (int rep = 0; rep <= DUP_MISC; ++rep) norm_rows(XOUT, CTXB, args.in[I_FNORM] + l * DM, modl, 3, XN, gw, NGW, lane);
        SEAM();
        { pg8::Gemm g{XN, (const bf16*)((const unsigned char*)WL + W_GU), NROWS, GUN, DM}; pg8::StaticOrder S; S.init(NROWS, GUN, G, bx);
          pg8::EpiGU E{HB};
          for (int rep = 0; rep <= DUP_GEMM; ++rep) pg8::gemm_phase<pg8::EpiGU, pg8::StaticOrder, true, true>(lds, g, S, E); }
        SEAM();
        { pg8::Gemm g{HB, (const bf16*)((const unsigned char*)WL + W_DN), NROWS, DM, FF}; pg8::StaticOrder S; S.init(NROWS, DM, G, bx);
          pg8::EpiRes E{XOUT, CTXB, XOUT, CTXB, modl + 5 * 1024};
          pg8::gemm_phase<pg8::EpiRes, pg8::StaticOrder, true, true>(lds, g, S, E);
          if (DUP_GEMM) { __syncthreads(); pg8::EpiRes E2{XOUT, CTXB, XOUT, CTXB, (const float*)(ws + WS_CTL + 32768)}; pg8::gemm_phase<pg8::EpiRes, pg8::StaticOrder, true, true>(lds, g, S, E2); } }
        SEAM();
    }
}

extern "C" void kernel_launch(void* const* d_in, const int* in_sizes, int n_in, void* d_out, int out_size, void* d_ws, size_t ws_size, hipStream_t stream) {
    static int grid = 0;
    if (grid == 0) {
        if (n_in != 18 || ws_size < WS_END) { fprintf(stderr, "kernel_launch: unexpected n_in %d / ws_size %zu\n", n_in, ws_size); grid = -1; return; }
        int dev = 0, cus = 0, per_cu = 0;
        hipGetDevice(&dev); hipDeviceGetAttribute(&cus, hipDeviceAttributeMultiprocessorCount, dev);
        hipFuncSetAttribute((const void*)fwd, hipFuncAttributeMaxDynamicSharedMemorySize, LDS_BYTES);
        hipOccupancyMaxActiveBlocksPerMultiprocessor(&per_cu, (const void*)fwd, NWAVES * 64, LDS_BYTES);
        if (per_cu < 1) { fprintf(stderr, "kernel_launch: occupancy query says %d blocks per CU\n", per_cu); per_cu = 1; }
        (void)hipGetLastError();
        grid = cus;
    }
    if (grid < 0) return;
    if (hipMemsetAsync((char*)d_ws + WS_CTL, 0, CTL_ZERO_BYTES, stream) != hipSuccess) { fprintf(stderr, "kernel_launch: memset failed\n"); return; }
    Args a{};
    for (int i = 0; i < 18; ++i) a.in[i] = (const float*)d_in[i];
    a.out = (float*)d_out; a.ws = (unsigned char*)d_ws; a.ph_lo = 0; a.ph_hi = 0;
    void* kargs[] = {&a};
    hipError_t e = hipLaunchCooperativeKernel((const void*)fwd, dim3(grid), dim3(NWAVES * 64), kargs, LDS_BYTES, stream);
    if (e != hipSuccess) fprintf(stderr, "cooperative launch failed: %s (grid %d)\n", hipGetErrorString(e), grid);
}
```
